# Optimizing an MI355X kernel written in HIP

```python
import math
import jax, jax.numpy as jnp
from jax import lax
import numpy as np

D_MODEL = 1024
BATCH = 2
SEQ = 8192
DEPTH = 1
DEC_BATCH = 128
DEC_SEQ = 8
PAST_LEN = 8192
PAGE_SIZE = 128

GLA_HEADS = 4
GLA_DK = D_MODEL // 2 // GLA_HEADS
GLA_DV = D_MODEL // GLA_HEADS
GLA_QK = GLA_HEADS * GLA_DK
GLA_V = GLA_HEADS * GLA_DV
GLA_RANK = 16
GLA_NORMALIZER = 16.0
GLA_CHUNK = 16
DIL_GROUPS = ((128, 1), (512, 4), (2048, 16))
N_GROUPS = len(DIL_GROUPS)
DIL_HEADS = 8
DIL_HD = 64
DIL_WIDTH = DIL_HEADS * DIL_HD
DIL_QKV = N_GROUPS * DIL_WIDTH
Q_BLOCK = 128
ROPE_THETA = 10000.0
D_FF = (8 * D_MODEL // 3 + 127) // 128 * 128
CONV_W = 3
PLE_DIM = 256
ALPHA = (2.0 * DEPTH) ** 0.25
BETA = (8.0 * DEPTH) ** -0.25
NORM_EPS = 1e-5
IN_SPLITS = (GLA_QK, GLA_QK, GLA_V, GLA_V, GLA_RANK, DIL_QKV, DIL_QKV, DIL_QKV, D_MODEL, D_MODEL)
IN_COLS = sum(IN_SPLITS)
SPLIT_AT = tuple(int(s) for s in np.cumsum(IN_SPLITS)[:-1])

kernel_name = 'hybrid_gla_dilated_convffn_decoder'


def layer_norm(x, g, b):
    xf = x.astype(jnp.float32)
    mu = jnp.mean(xf, -1, keepdims=True)
    var = jnp.mean(jnp.square(xf - mu), -1, keepdims=True)
    y = (xf - mu) * lax.rsqrt(var + NORM_EPS) * g.astype(jnp.float32) + b.astype(jnp.float32)
    return y.astype(x.dtype)


def rope(x, pos):
    half = x.shape[-1] // 2
    inv = ROPE_THETA ** (-jnp.arange(half, dtype=jnp.float32) / half)
    ang = pos.astype(jnp.float32)[:, None] * inv[None, :]
    cos = jnp.cos(ang)[None, :, None, :]
    sin = jnp.sin(ang)[None, :, None, :]
    xf = x.astype(jnp.float32)
    x1, x2 = xf[..., :half], xf[..., half:]
    return jnp.concatenate([x1 * cos - x2 * sin, x2 * cos + x1 * sin], -1).astype(x.dtype)


def gla_recurrence(q, k, v, logd, s0):
    B, T, H, _ = q.shape
    DV = v.shape[-1]
    C = GLA_CHUNK
    pad = (-T) % C
    n = (T + pad) // C

    def blocks(a):
        a = jnp.pad(a.astype(jnp.float32), ((0, 0), (0, pad), (0, 0), (0, 0)))
        return a.reshape(B, n, C, H, a.shape[-1]).transpose(1, 0, 3, 2, 4)

    qc, kc, vc, gc = blocks(q), blocks(k), blocks(v), blocks(logd)
    causal = jnp.tril(jnp.ones((C, C), bool))

    def step(S, inp):
        qb, kb, vb, gb = inp
        b = jnp.cumsum(gb, axis=2)
        rel = jnp.where(causal[None, None, :, :, None],
                        b[:, :, :, None, :] - b[:, :, None, :, :], -jnp.inf)
        A = jnp.einsum('bhtk,bhsk,bhtsk->bhts', qb, kb, jnp.exp(rel))
        o = jnp.einsum('bhtk,bhkv->bhtv', qb * jnp.exp(b), S) + jnp.einsum('bhts,bhsv->bhtv', A, vb)
        b_last = b[:, :, -1, :]
        S = jnp.exp(b_last)[..., None] * S + jnp.einsum(
            'bhsk,bhsv->bhkv', kb * jnp.exp(b_last[:, :, None, :] - b), vb)
        return S, o

    S, o = lax.scan(step, s0.astype(jnp.float32), (qc, kc, vc, gc))
    o = o.transpose(1, 0, 3, 2, 4).reshape(B, n * C, H, DV)[:, :T]
    return o, S


def dilated_attention(qs, ks, vs, offsets, block):
    B, T, H, hd = qs[0].shape
    nb = T // block
    scale = DIL_HD ** -0.5

    def one_block(bi):
        t0 = bi * block
        outs, lses = [], []
        for (w, r), q, k, v, off in zip(DIL_GROUPS, qs, ks, vs, offsets):
            n_keys = w // r + 1
            qb = lax.dynamic_slice_in_dim(q, t0, block, axis=1).astype(jnp.float32)
            idx = off + t0 + jnp.arange(block)[:, None] - r * jnp.arange(n_keys)[None, :]
            valid = idx >= 0
            idx = jnp.maximum(idx, 0)
            kg = jnp.take(k, idx, axis=1).astype(jnp.float32)
            vg = jnp.take(v, idx, axis=1).astype(jnp.float32)
            s = jnp.einsum('bthd,btnhd->bthn', qb, kg) * scale
            s = jnp.where(valid[None, :, None, :], s, -1e30)
            m = jnp.max(s, -1, keepdims=True)
            pe = jnp.exp(s - m)
            den = jnp.sum(pe, -1)
            outs.append(jnp.einsum('bthn,btnhd->bthd', pe, vg) / den[..., None])
            lses.append(m[..., 0] + jnp.log(den))
        wts = jax.nn.softmax(jnp.stack(lses, 0), axis=0)
        return jnp.sum(wts[..., None] * jnp.stack(outs, 0), axis=0)

    out = lax.map(one_block, jnp.arange(nb))
    return out.transpose(1, 0, 2, 3, 4).reshape(B, T, H, hd)


def conv_ffn(x, conv_prev, w_up, conv_w, conv_b, w_down):
    a, u = jnp.split(x @ w_up, 2, axis=-1)
    T = a.shape[1]
    ext = jnp.concatenate([conv_prev.astype(a.dtype), a], axis=1)
    c = conv_b
    for j in range(CONV_W):
        c = c + conv_w[j] * ext[:, j:j + T]
    y = (jax.nn.gelu(c, approximate=False) * u) @ w_down
    return y, ext[:, T:]


def trunk_layer(x, pe, pos, s0, conv_prev, kv_cache, q_block,
                w_in, w_gk_b, b_gk, gla_norm, w_br_gla, w_br_dil, w_out, ln1_g, ln1_b,
                w_up, conv_w, conv_b, w_down, ln2_g, ln2_b, w_ple_gate, w_ple_proj, ln3_g, ln3_b):
    B, T, _ = x.shape
    h = x @ w_in
    gq, gk, gv, gg, g_lr, dq, dk, dv, gate_a, gate_b = jnp.split(h, SPLIT_AT, axis=-1)

    logd = jax.nn.log_sigmoid((g_lr @ w_gk_b + b_gk).astype(jnp.float32)) / GLA_NORMALIZER
    o, S = gla_recurrence(gq.reshape(B, T, GLA_HEADS, GLA_DK) * (GLA_DK ** -0.5),
                          gk.reshape(B, T, GLA_HEADS, GLA_DK),
                          gv.reshape(B, T, GLA_HEADS, GLA_DV),
                          logd.reshape(B, T, GLA_HEADS, GLA_DK), s0)
    o = o * lax.rsqrt(jnp.mean(jnp.square(o), -1, keepdims=True) + NORM_EPS) * gla_norm.astype(jnp.float32)
    o = o * jax.nn.silu(gg.reshape(B, T, GLA_HEADS, GLA_DV).astype(jnp.float32))
    ya = o.reshape(B, T, GLA_V).astype(x.dtype) @ w_br_gla

    dq = dq.reshape(B, T, N_GROUPS, DIL_HEADS, DIL_HD)
    dk = dk.reshape(B, T, N_GROUPS, DIL_HEADS, DIL_HD)
    dv = dv.reshape(B, T, N_GROUPS, DIL_HEADS, DIL_HD)
    qs = [rope(dq[:, :, g], pos) for g in range(N_GROUPS)]
    ks = [rope(dk[:, :, g], pos) for g in range(N_GROUPS)]
    vs = [dv[:, :, g] for g in range(N_GROUPS)]
    if kv_cache is None:
        keys, vals, offs = ks, vs, [0] * N_GROUPS
        new_kv = [jnp.stack([k, v], 2)[:, -min(w, T):] for (w, _), k, v in zip(DIL_GROUPS, ks, vs)]
    else:
        keys = [jnp.concatenate([c[:, :, 0].astype(k.dtype), k], 1) for c, k in zip(kv_cache, ks)]
        vals = [jnp.concatenate([c[:, :, 1].astype(v.dtype), v], 1) for c, v in zip(kv_cache, vs)]
        offs = [c.shape[1] for c in kv_cache]
        new_kv = [jnp.stack([k, v], 2) for k, v in zip(ks, vs)]
    yb = dilated_attention(qs, keys, vals, offs, q_block)
    yb = yb.reshape(B, T, DIL_WIDTH).astype(x.dtype) @ w_br_dil

    m = jax.nn.sigmoid(gate_a) * ya + jax.nn.sigmoid(gate_b) * yb
    x = layer_norm(ALPHA * x + m @ w_out, ln1_g, ln1_b)

    f, conv_new = conv_ffn(x, conv_prev, w_up, conv_w, conv_b, w_down)
    x = layer_norm(ALPHA * x + f, ln2_g, ln2_b)

    x = layer_norm(ALPHA * x + jax.nn.sigmoid(x @ w_ple_gate) * (pe @ w_ple_proj), ln3_g, ln3_b)
    return x, S.astype(s0.dtype), conv_new, new_kv


def setup_inputs(seed: int = 0) -> dict:
    key = jax.random.key(seed)
    ks = jax.random.split(key, 28)
    f32 = jnp.float32

    def nrm(k, shape, scale=1.0):
        return jax.random.normal(k, shape, f32) * scale

    n_kv = [min(w, PAST_LEN) for w, _ in DIL_GROUPS]
    return {
        'x_prompt': nrm(ks[0], (BATCH, SEQ, D_MODEL)),
        'x_sample': nrm(ks[1], (DEC_BATCH, DEC_SEQ, D_MODEL)),
        'p_prompt': nrm(ks[2], (DEPTH, BATCH, SEQ, PLE_DIM)),
        'p_sample': nrm(ks[3], (DEPTH, DEC_BATCH, DEC_SEQ, PLE_DIM)),
        'state_gla': nrm(ks[4], (DEPTH, DEC_BATCH, GLA_HEADS, GLA_DK, GLA_DV), 0.5),
        'cache_conv': nrm(ks[5], (DEPTH, DEC_BATCH, CONV_W - 1, D_FF)),
        'cache_kv_w128': nrm(ks[6], (DEPTH, DEC_BATCH, n_kv[0], 2, DIL_HEADS, DIL_HD)),
        'cache_kv_w512': nrm(ks[7], (DEPTH, DEC_BATCH, n_kv[1], 2, DIL_HEADS, DIL_HD)),
        'cache_kv_w2048': nrm(ks[8], (DEPTH, DEC_BATCH, n_kv[2], 2, DIL_HEADS, DIL_HD)),
        'w_in': nrm(ks[9], (DEPTH, D_MODEL, IN_COLS), D_MODEL ** -0.5),
        'w_gk_b': nrm(ks[10], (DEPTH, GLA_RANK, GLA_QK), GLA_RANK ** -0.5),
        'b_gk': nrm(ks[11], (DEPTH, GLA_QK), 0.1),
        'gla_norm': 1.0 + nrm(ks[12], (DEPTH, GLA_DV), 0.02),
        'w_br_gla': nrm(ks[13], (DEPTH, GLA_V, D_MODEL), GLA_V ** -0.5),
        'w_br_dil': nrm(ks[14], (DEPTH, DIL_WIDTH, D_MODEL), DIL_WIDTH ** -0.5),
        'w_out': nrm(ks[15], (DEPTH, D_MODEL, D_MODEL), BETA * D_MODEL ** -0.5),
        'ln1_g': 1.0 + nrm(ks[16], (DEPTH, D_MODEL), 0.02),
        'ln1_b': nrm(ks[17], (DEPTH, D_MODEL), 0.02),
        'w_up': nrm(ks[18], (DEPTH, D_MODEL, 2 * D_FF), D_MODEL ** -0.5),
        'conv_w': nrm(ks[19], (DEPTH, CONV_W, D_FF), CONV_W ** -0.5),
        'conv_b': nrm(ks[20], (DEPTH, D_FF), 0.02),
        'w_down': nrm(ks[21], (DEPTH, D_FF, D_MODEL), BETA * D_FF ** -0.5),
        'ln2_g': 1.0 + nrm(ks[22], (DEPTH, D_MODEL), 0.02),
        'ln2_b': nrm(ks[23], (DEPTH, D_MODEL), 0.02),
        'w_ple_gate': nrm(ks[24], (DEPTH, D_MODEL, D_MODEL), D_MODEL ** -0.5),
        'w_ple_proj': nrm(ks[25], (DEPTH, PLE_DIM, D_MODEL), BETA * PLE_DIM ** -0.5),
        'ln3_g': 1.0 + nrm(ks[26], (DEPTH, D_MODEL), 0.02),
        'ln3_b': nrm(ks[27], (DEPTH, D_MODEL), 0.02),
    }


def reference(x_prompt, x_sample, p_prompt, p_sample, state_gla, cache_conv,
              cache_kv_w128, cache_kv_w512, cache_kv_w2048,
              w_in, w_gk_b, b_gk, gla_norm, w_br_gla, w_br_dil, w_out, ln1_g, ln1_b,
              w_up, conv_w, conv_b, w_down, ln2_g, ln2_b, w_ple_gate, w_ple_proj, ln3_g, ln3_b):
    Bp, Tp, _ = x_prompt.shape
    Ts = x_sample.shape[1]
    pos_p = jnp.arange(Tp, dtype=jnp.int32)
    pos_s = PAST_LEN + jnp.arange(Ts, dtype=jnp.int32)
    y_prompt, y_sample = x_prompt, x_sample
    gla_p, gla_s, conv_p, conv_s = [], [], [], []
    kv_p = [[] for _ in range(N_GROUPS)]
    kv_s = [[] for _ in range(N_GROUPS)]
    for i in range(DEPTH):
        lw = (w_in[i], w_gk_b[i], b_gk[i], gla_norm[i], w_br_gla[i], w_br_dil[i], w_out[i],
              ln1_g[i], ln1_b[i], w_up[i], conv_w[i], conv_b[i], w_down[i], ln2_g[i], ln2_b[i],
              w_ple_gate[i], w_ple_proj[i], ln3_g[i], ln3_b[i])
        s0 = jnp.zeros((Bp, GLA_HEADS, GLA_DK, GLA_DV), state_gla.dtype)
        c0 = jnp.zeros((Bp, CONV_W - 1, D_FF), x_prompt.dtype)
        y_prompt, sp, cp, kvp = trunk_layer(y_prompt, p_prompt[i], pos_p, s0, c0, None, Q_BLOCK, *lw)
        y_sample, ss, cs, kvs = trunk_layer(
            y_sample, p_sample[i], pos_s, state_gla[i], cache_conv[i],
            (cache_kv_w128[i], cache_kv_w512[i], cache_kv_w2048[i]), 1, *lw)
        gla_p.append(sp)
        gla_s.append(ss)
        conv_p.append(cp)
        conv_s.append(cs)
        for g in range(N_GROUPS):
            kv_p[g].append(kvp[g])
            kv_s[g].append(kvs[g])
    return (y_prompt, y_sample, jnp.stack(gla_p), jnp.stack(gla_s), jnp.stack(conv_p), jnp.stack(conv_s),
            jnp.stack(kv_p[0]), jnp.stack(kv_p[1]), jnp.stack(kv_p[2]),
            jnp.stack(kv_s[0]), jnp.stack(kv_s[1]), jnp.stack(kv_s[2]))
```

```cpp
#include <hip/hip_runtime.h>
#include <cstdio>
#include <cstdint>
#define GAS __attribute__((address_space(1)))
#define LAS __attribute__((address_space(3)))
namespace pg8 {
#define PG8_LAS __attribute__((address_space(3)))
typedef unsigned short bf16_t;
typedef short bf16x8 __attribute__((ext_vector_type(8)));
typedef float f32x4 __attribute__((ext_vector_type(4)));
typedef unsigned u32x4 __attribute__((ext_vector_type(4)));
constexpr int BM = 256, BK = 64, HALF = 128, HTB = HALF * BK * 2  , STAGE_BYTES = 8 * HTB, NXCD = 8, WGM = 8;

__host__ __device__ __forceinline__ int lds_byte(int r, int c) { const int st = (r >> 4) * 2 + (c >> 5), rr = r & 15, cc = c & 31, ob = rr * 64 + cc * 2; return st * 1024 + (ob ^ (((ob >> 9) & 1) << 5)); }
__host__ __device__ __forceinline__ void stage_rc(int b, int& R, int& C) { const int st = b / 1024, sb = b % 1024, swz = sb ^ (((sb >> 9) & 1) << 5); R = (st >> 1) * 16 + swz / 64; C = (st & 1) * 32 + (swz % 64) / 2; }
__host__ __device__ __forceinline__ int perm32(int rho) { const int n = rho >> 4, i = rho & 15; return 8 * (i >> 2) + 4 * n + (i & 3); }

struct Unit { int pm, pn; };
struct Gemm { const bf16_t* A; const bf16_t* Bt; int M, N, K; };

struct StaticOrder {
    int nM, nN, nwg, G, c;
    __host__ __device__ void init(int M, int N, int G_, int c_) { nM = M / BM; nN = N / BM; nwg = nM * nN; G = G_; c = c_; }
    __host__ __device__ bool next(int i, Unit& u) const {
        const long L = (long)i * G + c; if (L >= nwg) return false;
        int wgid = (int)L; { const int q = nwg / NXCD, r = nwg % NXCD, xcd = wgid % NXCD, off = wgid / NXCD; wgid = (xcd < r ? xcd * (q + 1) : r * (q + 1) + (xcd - r) * q) + off; }
        const int nig = WGM * nN, gid = wgid / nig, fm = gid * WGM, gsz = (nM - fm) < WGM ? (nM - fm) : WGM;
        u.pm = fm + ((wgid % nig) % gsz); u.pn = (wgid % nig) / gsz; return true;
    }
    __device__ __forceinline__ void a_ready(const Unit&) const {}
    __device__ __forceinline__ void done(const Unit&) const {}
};

__device__ __forceinline__ unsigned cvt_pk_bf16(float lo, float hi) { unsigned r; asm volatile("v_cvt_pk_bf16_f32 %0, %1, %2" : "=v"(r) : "v"(lo), "v"(hi)); return r; }
typedef float f32x2 __attribute__((ext_vector_type(2)));
__device__ __forceinline__ f32x2 gelu_pk(f32x2 v) {
    const f32x2 av = __builtin_elementwise_abs(v), d = av * 0.2316418882f + 1.0f;
    f32x2 t; t.x = __builtin_amdgcn_rcpf(d.x); t.y = __builtin_amdgcn_rcpf(d.y);
    f32x2 q = t * 0.5307027145f + (-0.7265760135f); q = q * t + 0.7107068705f; q = q * t + (-0.142248368f); q = q * t + 0.127414796f; q = q * t;
    const f32x2 s = (v * v) * (-0.72134752044f);
    f32x2 e; e.x = __builtin_amdgcn_exp2f(s.x); e.y = __builtin_amdgcn_exp2f(s.y);
    const f32x2 m = v * (q * e), r = v - m;
    f32x2 o; o.x = v.x < 0.f ? m.x : r.x; o.y = v.y < 0.f ? m.y : r.y; return o;
}
template <class Epi, class Sched, bool ALIGN_EPI = false, bool SP2 = false>
__device__ __forceinline__ void gemm_phase(PG8_LAS unsigned char* lds, const Gemm g, const Sched& S, const Epi& E) {
    const int tid = threadIdx.x, wid = __builtin_amdgcn_readfirstlane(tid >> 6), lane = tid & 63, wr = wid >> 2, wc = wid & 3, fr = lane & 15, fq = lane >> 4;
    const int K = g.K, nt = K / BK;
    unsigned voffA[2], voffB[2];
#pragma unroll
    for (int i = 0; i < 2; ++i) { int R, C; stage_rc(tid * 16 + i * 8192, R, C); const int Rb = Epi::PERM ? ((R & ~31) + perm32(R & 31)) : R;
        voffA[i] = (unsigned)(R * K + C) * 2u; voffB[i] = (unsigned)(Rb * K + C) * 2u; }
    const size_t kstep = (size_t)(BK * 2);
    const size_t hstep = (size_t)HALF * K * 2;
    const size_t tstep = 2 * hstep;
    const unsigned ldsw = (unsigned)wid * 1024u;
    const int aoff = lds_byte(wr * 64 + fr, fq * 8), boff = lds_byte(wc * 32 + fr, fq * 8);
#define PG8_SA(b, h) (((b) * 2 + (h)) * HTB)
#define PG8_SB(b, h) ((4 + (b) * 2 + (h)) * HTB)
#define PG8_STAGE(bufoff, gbase, voff) do { _Pragma("unroll") for (int _i = 0; _i < 2; ++_i) \
        __builtin_amdgcn_global_load_lds((const unsigned*)((const char*)(gbase) + (voff)[_i]), (PG8_LAS unsigned*)(lds + (bufoff) + ldsw + _i * 8192), 16, 0, 0); } while (0)
#define PG8_LDA(dst, b, h) do { _Pragma("unroll") for (int m = 0; m < 4; ++m) _Pragma("unroll") for (int k = 0; k < 2; ++k) dst[m][k] = *(const PG8_LAS bf16x8*)(lds + PG8_SA(b, h) + aoff + m * 2048 + k * 1024); } while (0)
#define PG8_LDB(dst, b, h) do { _Pragma("unroll") for (int n = 0; n < 2; ++n) _Pragma("unroll") for (int k = 0; k < 2; ++k) dst[n][k] = *(const PG8_LAS bf16x8*)(lds + PG8_SB(b, h) + boff + n * 2048 + k * 1024); } while (0)
#define PG8_MMA(ai, bj, At, Bt) do { __builtin_amdgcn_s_setprio(1); _Pragma("unroll") for (int m = 0; m < 4; ++m) _Pragma("unroll") for (int n = 0; n < 2; ++n) _Pragma("unroll") for (int k = 0; k < 2; ++k) \
        acc[ai][bj][m][n] = __builtin_amdgcn_mfma_f32_16x16x32_bf16(Bt[n][k], At[m][k], acc[ai][bj][m][n], 0, 0, 0); __builtin_amdgcn_s_setprio(0); } while (0)
#define PG8_WAIT_V(n) asm volatile("s_waitcnt vmcnt(" #n ")" ::: "memory")
#define PG8_WAIT_L(n) asm volatile("s_waitcnt lgkmcnt(" #n ")" ::: "memory")
#define PG8_BAR __builtin_amdgcn_s_barrier()
#define PG8_SCHED __builtin_amdgcn_sched_barrier(0)
    Unit cur, nxt; int ui = 0;
    if (!S.next(0, cur)) return;
    f32x4 acc[2][2][4][2];
#pragma unroll
    for (int a = 0; a < 2; ++a)
#pragma unroll
        for (int b = 0; b < 2; ++b)
#pragma unroll
            for (int m = 0; m < 4; ++m)
#pragma unroll
                for (int n = 0; n < 2; ++n) acc[a][b][m][n] = (f32x4){0.f, 0.f, 0.f, 0.f};
    bf16x8 At[4][2], B0[2][2], B1[2][2];
    const char* cA = (const char*)g.A + (size_t)cur.pm * tstep; const char* cB = (const char*)g.Bt + (size_t)cur.pn * tstep;
    S.a_ready(cur);
    if constexpr (SP2) {
        PG8_STAGE(PG8_SB(0, 0), cB, voffB); PG8_STAGE(PG8_SB(0, 1), cB + hstep, voffB); PG8_STAGE(PG8_SA(0, 0), cA, voffA); PG8_STAGE(PG8_SA(0, 1), cA + hstep, voffA);
        if (wr == 1) PG8_BAR;
        PG8_WAIT_V(2); PG8_BAR;
        PG8_STAGE(PG8_SB(1, 0), cB + kstep, voffB); PG8_STAGE(PG8_SA(1, 0), cA + kstep, voffA); PG8_STAGE(PG8_SB(1, 1), cB + hstep + kstep, voffB);
        PG8_WAIT_V(6); PG8_BAR;
    } else {
        PG8_STAGE(PG8_SB(0, 0), cB, voffB); PG8_STAGE(PG8_SA(0, 0), cA, voffA); PG8_STAGE(PG8_SB(0, 1), cB + hstep, voffB); PG8_STAGE(PG8_SA(0, 1), cA + hstep, voffA);
        if (wr == 1) PG8_BAR;
        PG8_WAIT_V(4); PG8_BAR;
        PG8_STAGE(PG8_SB(1, 0), cB + kstep, voffB); PG8_STAGE(PG8_SA(1, 0), cA + kstep, voffA); PG8_STAGE(PG8_SB(1, 1), cB + hstep + kstep, voffB);
        PG8_WAIT_V(6); PG8_BAR;
    }
    for (;;) {
        const bool has_next = S.next(ui + 1, nxt);
        const char* nA = has_next ? (const char*)g.A + (size_t)nxt.pm * tstep : cA; const char* nB = has_next ? (const char*)g.Bt + (size_t)nxt.pn * tstep : cB;
        for (int t = 0; t < nt; t += 2) {
            const bool last = (t == nt - 2);
            const char* a1 = cA + (size_t)(t + 1) * kstep;
            const char* a2 = last ? nA : cA + (size_t)(t + 2) * kstep; const char* b2 = last ? nB : cB + (size_t)(t + 2) * kstep;
            const char* a3 = a2 + kstep; const char* b3 = b2 + kstep;
            if (last && has_next) S.a_ready(nxt);
            if constexpr (SP2) {
            PG8_LDB(B0, 0, 0); PG8_LDB(B1, 0, 1); PG8_SCHED; PG8_LDA(At, 0, 0); PG8_STAGE(PG8_SA(1, 1), a1 + hstep, voffA);
            PG8_WAIT_V(8); PG8_WAIT_L(0); PG8_BAR; PG8_MMA(0, 0, At, B0); PG8_MMA(0, 1, At, B1); PG8_BAR; PG8_SCHED;
            PG8_LDA(At, 0, 1); PG8_STAGE(PG8_SB(0, 0), b2, voffB); PG8_STAGE(PG8_SB(0, 1), b2 + hstep, voffB); PG8_STAGE(PG8_SA(0, 0), a2, voffA);
            PG8_WAIT_V(8); PG8_WAIT_L(0); PG8_BAR; PG8_MMA(1, 0, At, B0); PG8_MMA(1, 1, At, B1); PG8_BAR; PG8_SCHED;
            PG8_LDB(B0, 1, 0); PG8_LDB(B1, 1, 1); PG8_SCHED; PG8_LDA(At, 1, 0); PG8_STAGE(PG8_SA(0, 1), a2 + hstep, voffA);
            PG8_WAIT_V(8); PG8_WAIT_L(0); PG8_BAR; PG8_MMA(0, 0, At, B0); PG8_MMA(0, 1, At, B1); PG8_BAR; PG8_SCHED;
            PG8_LDA(At, 1, 1); PG8_STAGE(PG8_SB(1, 0), b3, voffB); PG8_STAGE(PG8_SB(1, 1), b3 + hstep, voffB); PG8_STAGE(PG8_SA(1, 0), a3, voffA);
            PG8_WAIT_V(8); PG8_WAIT_L(0); PG8_BAR; PG8_MMA(1, 0, At, B0); PG8_MMA(1, 1, At, B1); PG8_BAR; PG8_SCHED;
            } else {
            PG8_LDB(B0, 0, 0); PG8_SCHED; PG8_LDA(At, 0, 0); PG8_STAGE(PG8_SA(1, 1), a1 + hstep, voffA);
            PG8_WAIT_L(8); PG8_BAR; PG8_WAIT_L(0); PG8_MMA(0, 0, At, B0); PG8_BAR; PG8_SCHED;
            PG8_LDB(B1, 0, 1); PG8_STAGE(PG8_SB(0, 0), b2, voffB);
            PG8_BAR; PG8_WAIT_L(0); PG8_MMA(0, 1, At, B1); PG8_BAR;
            PG8_LDA(At, 0, 1); PG8_STAGE(PG8_SA(0, 0), a2, voffA);
            PG8_BAR; PG8_WAIT_L(0); PG8_MMA(1, 0, At, B0); PG8_BAR; PG8_SCHED;
            PG8_STAGE(PG8_SB(0, 1), b2 + hstep, voffB);
            PG8_WAIT_V(6); PG8_BAR; PG8_MMA(1, 1, At, B1); PG8_BAR;
            PG8_LDB(B0, 1, 0); PG8_SCHED; PG8_LDA(At, 1, 0); PG8_STAGE(PG8_SA(0, 1), a2 + hstep, voffA);
            PG8_WAIT_L(8); PG8_BAR; PG8_WAIT_L(0); PG8_MMA(0, 0, At, B0); PG8_BAR; PG8_SCHED;
            PG8_LDB(B1, 1, 1); PG8_STAGE(PG8_SB(1, 0), b3, voffB);
            PG8_BAR; PG8_WAIT_L(0); PG8_MMA(0, 1, At, B1); PG8_BAR;
            PG8_LDA(At, 1, 1); PG8_STAGE(PG8_SA(1, 0), a3, voffA);
            PG8_BAR; PG8_WAIT_L(0); PG8_MMA(1, 0, At, B0); PG8_BAR; PG8_SCHED;
            PG8_STAGE(PG8_SB(1, 1), b3 + hstep, voffB);
            PG8_WAIT_V(6); PG8_BAR; PG8_MMA(1, 1, At, B1); PG8_BAR;
            }
        }
        if constexpr (ALIGN_EPI) { if (wr == 0) PG8_BAR; }
        if constexpr (!Epi::AFTER_DRAIN) { E(acc, cur, wr, wc, fr, fq); S.done(cur); }
        if (!has_next) break;
#pragma unroll
        for (int a = 0; a < 2; ++a)
#pragma unroll
            for (int b = 0; b < 2; ++b)
#pragma unroll
                for (int m = 0; m < 4; ++m)
#pragma unroll
                    for (int n = 0; n < 2; ++n) acc[a][b][m][n] = (f32x4){0.f, 0.f, 0.f, 0.f};
        cur = nxt; cA = nA; cB = nB; ++ui;
        if constexpr (ALIGN_EPI) { if (wr == 1) PG8_BAR; }
    }
    PG8_WAIT_V(0);
    if constexpr (!ALIGN_EPI) { if (wr == 0) PG8_BAR; }
    PG8_BAR;
    if constexpr (Epi::AFTER_DRAIN) { E.fused(acc, cur, wr, wc, fr, fq, lds, wid, lane); S.done(cur); }
#undef PG8_SA
#undef PG8_SB
#undef PG8_STAGE
#undef PG8_LDA
#undef PG8_LDB
#undef PG8_MMA
#undef PG8_WAIT_V
#undef PG8_WAIT_L
#undef PG8_BAR
#undef PG8_SCHED
}
}
#define RLX_AGENT __ATOMIC_RELAXED, __HIP_MEMORY_SCOPE_AGENT
#define XB_TMO      128
#define XB_XCNT(j)  (256  + 64 * (j))
#define XB_XSUB(j)  (1280 + 64 * (j))
#define XB_XGEN(j)  (2304 + 64 * (j))
#define XB_TOP      3328
#define XB_TOPGEN   3392
#define XCD_BAR_WORDS 3456
#define XB_SPIN_CAP (1u << 18)

__device__ __forceinline__ unsigned xb_ld(unsigned* p)              { return __hip_atomic_load(p, __ATOMIC_RELAXED, __HIP_MEMORY_SCOPE_AGENT); }
__device__ __forceinline__ unsigned xb_add(unsigned* p, unsigned v) { return __hip_atomic_fetch_add(p, v, __ATOMIC_RELAXED, __HIP_MEMORY_SCOPE_AGENT); }
__device__ __forceinline__ unsigned xb_xcc_id() { return (unsigned)__builtin_amdgcn_s_getreg((3 << 11) | 20) & 0xFu; }
#define XB_SPIN(cond, bar) do { unsigned _sp = 0; while (cond) { __builtin_amdgcn_s_sleep(1); \
    if ((++_sp & 255u) == 0u) { if (xb_ld(&(bar)[XB_TMO])) break; if (_sp > XB_SPIN_CAP) { atomicAdd(&(bar)[XB_TMO], 1u); break; } } } } while (0)

struct XcdBarrier {
    unsigned* bar; unsigned x;
    volatile LAS unsigned* st;
};

__device__ __forceinline__ XcdBarrier xcd_barrier_post(unsigned* bar, volatile LAS unsigned* st) {
    XcdBarrier b; b.bar = bar; b.x = xb_xcc_id(); b.st = st;
    if (threadIdx.x == 0) (void)xb_add(&bar[XB_XCNT(b.x)], 1u);
    return b;
}
__device__ __forceinline__ void xcd_barrier_complete(unsigned* bar, unsigned x, unsigned& nloc, unsigned& nx) {
    const unsigned G = gridDim.x * gridDim.y * gridDim.z;
    unsigned sum, cnt, mine, sp = 0u;
    for (;;) {
        sum = 0u; cnt = 0u; mine = 0u;
#pragma unroll
        for (unsigned j = 0; j < 16; ++j) { const unsigned c = xb_ld(&bar[XB_XCNT(j)]); sum += c; cnt += (c > 0u) ? 1u : 0u; mine = (j == x) ? c : mine; }
        if (sum == G) break;
        __builtin_amdgcn_s_sleep(1);
        if ((++sp & 255u) == 0u) { if (xb_ld(&bar[XB_TMO])) break; if (sp > XB_SPIN_CAP) { atomicAdd(&bar[XB_TMO], 1u); break; } }
    }
    nloc = mine > 0u ? mine : 1u; nx = cnt > 0u ? cnt : 1u;
}

__device__ __forceinline__ void xcd_barrier(const XcdBarrier& b) {
    asm volatile("s_waitcnt vmcnt(0)" ::: "memory");
    __syncthreads();
    if (threadIdx.x == 0) {
        unsigned* bar = b.bar;
        __builtin_amdgcn_s_waitcnt(0);
        unsigned nloc = b.st[0], nx = b.st[1];
        if (nloc == 0u) { xcd_barrier_complete(bar, b.x, nloc, nx); b.st[0] = nloc; b.st[1] = nx; }
        const unsigned old = xb_add(&bar[XB_XSUB(b.x)], 1u);
        const unsigned gen = old / nloc;
        if (old + 1u == (gen + 1u) * nloc) {
            __builtin_amdgcn_fence(__ATOMIC_RELEASE, "agent");
            asm volatile("s_waitcnt vmcnt(0)" ::: "memory");
            const unsigned og = xb_add(&bar[XB_TOP], 1u);
            const unsigned tg = og / nx;
            if (og + 1u == (tg + 1u) * nx) xb_add(&bar[XB_TOPGEN], 1u);
            else XB_SPIN(xb_ld(&bar[XB_TOPGEN]) == tg, bar);
            __builtin_amdgcn_fence(__ATOMIC_ACQUIRE, "agent");
            xb_add(&bar[XB_XGEN(b.x)], 1u);
            asm volatile("s_waitcnt vmcnt(0)" ::: "memory");
        } else {
            XB_SPIN(xb_ld(&bar[XB_XGEN(b.x)]) == gen, bar);
            __builtin_amdgcn_fence(__ATOMIC_ACQUIRE, "agent");
            asm volatile("s_waitcnt vmcnt(0)" ::: "memory");
        }
    }
    __syncthreads();
}

typedef unsigned short bf16;
typedef unsigned u32x4 __attribute__((ext_vector_type(4)));
typedef unsigned u32x2 __attribute__((ext_vector_type(2)));
typedef float f32x4 __attribute__((ext_vector_type(4)));
typedef float f32x2 __attribute__((ext_vector_type(2)));
typedef short bf16x8 __attribute__((ext_vector_type(8)));
typedef short v4s __attribute__((ext_vector_type(4)));
typedef __bf16 bf16x2v __attribute__((ext_vector_type(2)));

constexpr int NWAVES = 8, NTHREADS = 512;
constexpr int DM = 1024, MP = 16384, MSMP = 1024, MROWS = 17408, TP = 8192;
constexpr int HLD = 9728;
constexpr int NIN = 9984;
constexpr int C_GQ = 0, C_GK = 512, C_GV = 1024, C_GG = 2048, C_DQ = 3072, C_DK = 4608, C_DV = 6144, C_GA = 7680, C_GB = 8704;
constexpr int FF = 2816;
constexpr float ALPHA = 1.189207115002721f;
constexpr float LN_EPS = 1e-5f;
constexpr float QSCALE_GLA = 0.08838834764831845f;
constexpr float QSCALE_DIL = 0.125f * 1.4426950408889634f;

constexpr size_t MiB = 1u << 20;
constexpr size_t WS_CTL = 0, CTL_ZERO_BYTES = 1 * MiB;
constexpr size_t WS_RCOS = 2 * MiB, WS_RSIN = 4 * MiB;
constexpr size_t WS_BIN = 8 * MiB, WS_BBG = 28 * MiB, WS_BBD = 30 * MiB, WS_BOUT = 31 * MiB, WS_BUP = 33 * MiB, WS_BDN = 44 * MiB, WS_BPG = 50 * MiB, WS_BPP = 52 * MiB;
constexpr size_t WS_XB = 64 * MiB, WS_PEB = 98 * MiB, WS_GLR = 107 * MiB, WS_DC = 109 * MiB, WS_LSE = 110 * MiB;
constexpr size_t WS_H = 128 * MiB, WS_LBUF = 452 * MiB, WS_SBUF = 484 * MiB, WS_OAT = 500 * MiB, WS_OD = 552 * MiB, WS_OG = 570 * MiB;
constexpr size_t WS_T = 604 * MiB, WS_MB = 672 * MiB, WS_R = 706 * MiB, WS_X1 = 774 * MiB, WS_X1B = 842 * MiB, WS_AB = 876 * MiB, WS_HM = 970 * MiB;
constexpr size_t WS_X2 = 1064 * MiB, WS_X2B = 1132 * MiB, WS_PP = 1166 * MiB, WS_END = 1234 * MiB;
static_assert(WS_BIN + (size_t)NIN * DM * 2 <= WS_BBG && WS_H + (size_t)MROWS * HLD * 2 <= WS_LBUF && WS_AB + (size_t)MROWS * FF * 2 <= WS_HM && WS_HM + (size_t)MROWS * FF * 2 <= WS_X2, "ws map");
constexpr int CW_BAR = 4096;

constexpr size_t OFF_Y = 0, OFF_GSP = 17825792, OFF_GSS = 18087936, OFF_CP = 34865152, OFF_CS = 34876416;
constexpr size_t OFF_KVP0 = 35597312, OFF_KVP1 = 35859456, OFF_KVP2 = 36908032, OFF_KVS0 = 41102336, OFF_KVS1 = 42150912, OFF_KVS2 = 43199488, OUT_TOTAL = 44248064;

constexpr int LDS_BYTES = 159744;
constexpr int LDS_MISC = 158720;

__device__ __forceinline__ unsigned pkbf(float lo, float hi) { f32x2 v = {lo, hi}; bf16x2v b = __builtin_convertvector(v, bf16x2v); return __builtin_bit_cast(unsigned, b); }
__device__ __forceinline__ bf16 f2bf(float x) { return (bf16)(pkbf(x, 0.f) & 0xffffu); }
__device__ __forceinline__ float bf2f(bf16 v) { return __uint_as_float((unsigned)v << 16); }
__device__ __forceinline__ float bflo(unsigned w) { return __uint_as_float(w << 16); }
__device__ __forceinline__ float bfhi(unsigned w) { return __uint_as_float(w & 0xffff0000u); }
__device__ __forceinline__ float sigm(float x) { return 1.0f / (1.0f + __expf(-x)); }
__device__ __forceinline__ float logsig16(float z) { return (fminf(z, 0.f) - __logf(1.0f + __expf(-fabsf(z)))) * 0.0625f; }
#define MFMA16(a, b, c) __builtin_amdgcn_mfma_f32_16x16x32_bf16((a), (b), (c), 0, 0, 0)
__device__ __forceinline__ bf16x8 ld_tr(const LAS unsigned char* base, int pitch, int k0, int colbyte0, int lane) {
    const int g = lane >> 4, q = (lane & 15) >> 2, p = lane & 3;
    const LAS unsigned char* a0 = base + (k0 + 8 * g + q) * pitch + colbyte0 + 8 * p;
    const v4s lo = __builtin_amdgcn_ds_read_tr16_b64_v4i16((LAS v4s*)a0);
    const v4s hi = __builtin_amdgcn_ds_read_tr16_b64_v4i16((LAS v4s*)(a0 + 4 * pitch));
    return (bf16x8){lo[0], lo[1], lo[2], lo[3], hi[0], hi[1], hi[2], hi[3]};
}
__device__ __forceinline__ bf16x8 pack8(const f32x4 a, const f32x4 b) {
    u32x4 w; w.x = pkbf(a[0], a[1]); w.y = pkbf(a[2], a[3]); w.z = pkbf(b[0], b[1]); w.w = pkbf(b[2], b[3]); return __builtin_bit_cast(bf16x8, w);
}

namespace pg8 {
struct EpiIn {
    static constexpr bool PERM = true, AFTER_DRAIN = false;
    bf16_t* H; float* GLR; const float* rcos; const float* rsin; float* out;
    __device__ __forceinline__ void operator()(const f32x4 (&acc)[2][2][4][2], const Unit& u, int wr, int wc, int fr, int fq) const {
        const int pn = u.pn;
        const int rowb = u.pm * BM + wr * 64 + fr;
        const int cb = wc * 32 + 8 * fq;
        if (pn == 38) {
            if (cb < 16) {
#pragma unroll
                for (int ai = 0; ai < 2; ++ai)
#pragma unroll
                    for (int m = 0; m < 4; ++m) { float* gp = GLR + (size_t)(rowb + ai * HALF + m * 16) * 16 + cb; *(f32x4*)gp = acc[ai][0][m][0]; *(f32x4*)(gp + 4) = acc[ai][0][m][1]; }
            }
            return;
        }
        const int mode = pn < 2 ? 0 : pn < 8 ? 1 : pn < 12 ? 2 : pn < 18 ? 3 : pn < 24 ? 4 : pn < 30 ? 5 : 6;
        const bool sample = u.pm >= 64;
        const int kvsel = (mode == 5) ? 1 : 0;
        const int pnr = (mode == 5) ? pn - 24 : pn - 18;
        const int g = pnr >> 1;
        const int W = 128 << (2 * g);
        const size_t offs = (g == 0) ? OFF_KVS0 : (g == 1) ? OFF_KVS1 : OFF_KVS2;
        const size_t offp = (g == 0) ? OFF_KVP0 : (g == 1) ? OFF_KVP1 : OFF_KVP2;
#pragma unroll
        for (int ai = 0; ai < 2; ++ai)
#pragma unroll
            for (int m = 0; m < 4; ++m) {
                const int row = rowb + ai * HALF + m * 16;
                bf16_t* hp = H + (size_t)row * HLD + pn * BM + cb;
                const int t = sample ? (row & 7) : (row & 8191);
                const int pos = sample ? 8192 + t : t;
                const int bidx = sample ? ((row - MP) >> 3) : (row >> 13);
                float* kvp = nullptr;
                if (mode == 4 || mode == 5) {
                    if (sample) kvp = out + offs + ((size_t)(bidx * 8 + t) * 2 + kvsel) * 512;
                    else if (t >= 8192 - W) kvp = out + offp + ((size_t)(bidx * W + (t - (8192 - W))) * 2 + kvsel) * 512;
                }
#pragma unroll
                for (int bj = 0; bj < 2; ++bj) {
                    f32x4 v0 = acc[ai][bj][m][0], v1 = acc[ai][bj][m][1];
                    const int cc = bj * HALF + cb;
                    const int hh = (pnr & 1) * 4 + (cc >> 6);
                    if (mode == 0) { v0 = v0 * QSCALE_GLA; v1 = v1 * QSCALE_GLA; }
                    else if (mode == 2) {
#pragma unroll
                        for (int e = 0; e < 4; ++e) { v0[e] = v0[e] * sigm(v0[e]); v1[e] = v1[e] * sigm(v1[e]); }
                    } else if (mode == 6) {
#pragma unroll
                        for (int e = 0; e < 4; ++e) { v0[e] = sigm(v0[e]); v1[e] = sigm(v1[e]); }
                    } else if (mode == 3 || mode == 4) {
                        const int i0 = (cc & 63) >> 1;
                        const f32x4 cs = *(const f32x4*)(rcos + pos * 32 + i0), sn = *(const f32x4*)(rsin + pos * 32 + i0);
                        const f32x4 x1 = {v0[0], v0[2], v1[0], v1[2]}, x2 = {v0[1], v0[3], v1[1], v1[3]};
                        f32x4 y1 = x1 * cs - x2 * sn, y2 = x2 * cs + x1 * sn;
                        if (mode == 4) { if (kvp) { float* o = kvp + hh * 64 + i0; *(f32x4*)o = y1; *(f32x4*)(o + 32) = y2; } }
                        else { y1 = y1 * QSCALE_DIL; y2 = y2 * QSCALE_DIL; }
                        v0 = (f32x4){y1[0], y2[0], y1[1], y2[1]}; v1 = (f32x4){y1[2], y2[2], y1[3], y2[3]};
                    } else if (mode == 5) {
                        if (kvp) { float* o = kvp + hh * 64 + (cc & 63); *(f32x4*)o = v0; *(f32x4*)(o + 4) = v1; }
                    }
                    u32x4 w; w.x = pkbf(v0[0], v0[1]); w.y = pkbf(v0[2], v0[3]); w.z = pkbf(v1[0], v1[1]); w.w = pkbf(v1[2], v1[3]);
                    *(u32x4*)(hp + bj * HALF) = w;
                }
            }
    }
};
struct EpiGateT {
    static constexpr bool PERM = true, AFTER_DRAIN = false;
    const bf16_t* G; int gld; float* T;
    __device__ __forceinline__ void operator()(const f32x4 (&acc)[2][2][4][2], const Unit& u, int wr, int wc, int fr, int fq) const {
        const int rowb = u.pm * BM + wr * 64 + fr, col0 = u.pn * BM + wc * 32 + 8 * fq;
#pragma unroll
        for (int ai = 0; ai < 2; ++ai)
#pragma unroll
            for (int m = 0; m < 4; ++m) { const size_t row = rowb + ai * HALF + m * 16;
#pragma unroll
                for (int bj = 0; bj < 2; ++bj) { const int c = col0 + bj * HALF; const u32x4 gw = *(const u32x4*)(G + row * gld + c);
                    f32x4 v0 = acc[ai][bj][m][0], v1 = acc[ai][bj][m][1];
                    v0 = v0 * (f32x4){bflo(gw.x), bfhi(gw.x), bflo(gw.y), bfhi(gw.y)}; v1 = v1 * (f32x4){bflo(gw.z), bfhi(gw.z), bflo(gw.w), bfhi(gw.w)};
                    float* tp = T + row * DM + c; *(f32x4*)tp = v0; *(f32x4*)(tp + 4) = v1; } }
    }
};
struct EpiGateM {
    static constexpr bool PERM = true, AFTER_DRAIN = false;
    const bf16_t* G; int gld; const float* T; bf16_t* O;
    __device__ __forceinline__ void operator()(const f32x4 (&acc)[2][2][4][2], const Unit& u, int wr, int wc, int fr, int fq) const {
        const int rowb = u.pm * BM + wr * 64 + fr, col0 = u.pn * BM + wc * 32 + 8 * fq;
#pragma unroll
        for (int ai = 0; ai < 2; ++ai)
#pragma unroll
            for (int m = 0; m < 4; ++m) { const size_t row = rowb + ai * HALF + m * 16;
#pragma unroll
                for (int bj = 0; bj < 2; ++bj) { const int c = col0 + bj * HALF; const u32x4 gw = *(const u32x4*)(G + row * gld + c);
                    const float* tp = T + row * DM + c; const f32x4 t0 = *(const f32x4*)tp, t1 = *(const f32x4*)(tp + 4);
                    f32x4 v0 = acc[ai][bj][m][0], v1 = acc[ai][bj][m][1];
                    v0 = t0 + v0 * (f32x4){bflo(gw.x), bfhi(gw.x), bflo(gw.y), bfhi(gw.y)}; v1 = t1 + v1 * (f32x4){bflo(gw.z), bfhi(gw.z), bflo(gw.w), bfhi(gw.w)};
                    u32x4 w; w.x = pkbf(v0[0], v0[1]); w.y = pkbf(v0[2], v0[3]); w.z = pkbf(v1[0], v1[1]); w.w = pkbf(v1[2], v1[3]);
                    *(u32x4*)(O + row * DM + c) = w; } }
    }
};
struct EpiRes {
    static constexpr bool PERM = true, AFTER_DRAIN = false;
    const float* resP; const float* resS; float* R;
    __device__ __forceinline__ void operator()(const f32x4 (&acc)[2][2][4][2], const Unit& u, int wr, int wc, int fr, int fq) const {
        const int rowb = u.pm * BM + wr * 64 + fr, col0 = u.pn * BM + wc * 32 + 8 * fq;
        const float* rb = (u.pm >= 64) ? resS - (size_t)MP * DM : resP;
#pragma unroll
        for (int ai = 0; ai < 2; ++ai)
#pragma unroll
            for (int m = 0; m < 4; ++m) { const size_t row = rowb + ai * HALF + m * 16;
#pragma unroll
                for (int bj = 0; bj < 2; ++bj) { const int c = col0 + bj * HALF; const float* xp = rb + row * DM + c;
                    const f32x4 x0 = *(const f32x4*)xp, x1 = *(const f32x4*)(xp + 4);
                    float* rp = R + row * DM + c; *(f32x4*)rp = x0 * ALPHA + acc[ai][bj][m][0]; *(f32x4*)(rp + 4) = x1 * ALPHA + acc[ai][bj][m][1]; } }
    }
};
struct EpiF32 {
    static constexpr bool PERM = true, AFTER_DRAIN = false;
    float* O;
    __device__ __forceinline__ void operator()(const f32x4 (&acc)[2][2][4][2], const Unit& u, int wr, int wc, int fr, int fq) const {
        const int rowb = u.pm * BM + wr * 64 + fr, col0 = u.pn * BM + wc * 32 + 8 * fq;
#pragma unroll
        for (int ai = 0; ai < 2; ++ai)
#pragma unroll
            for (int m = 0; m < 4; ++m) { const size_t row = rowb + ai * HALF + m * 16;
#pragma unroll
                for (int bj = 0; bj < 2; ++bj) { float* rp = O + row * DM + col0 + bj * HALF; *(f32x4*)rp = acc[ai][bj][m][0]; *(f32x4*)(rp + 4) = acc[ai][bj][m][1]; } }
    }
};
struct EpiPle {
    static constexpr bool PERM = true, AFTER_DRAIN = false;
    const float* X2; const float* PP; float* R;
    __device__ __forceinline__ void operator()(const f32x4 (&acc)[2][2][4][2], const Unit& u, int wr, int wc, int fr, int fq) const {
        const int rowb = u.pm * BM + wr * 64 + fr, col0 = u.pn * BM + wc * 32 + 8 * fq;
#pragma unroll
        for (int ai = 0; ai < 2; ++ai)
#pragma unroll
            for (int m = 0; m < 4; ++m) { const size_t row = rowb + ai * HALF + m * 16;
#pragma unroll
                for (int bj = 0; bj < 2; ++bj) { const size_t o = row * DM + col0 + bj * HALF;
                    const f32x4 x0 = *(const f32x4*)(X2 + o), x1 = *(const f32x4*)(X2 + o + 4), p0 = *(const f32x4*)(PP + o), p1 = *(const f32x4*)(PP + o + 4);
                    f32x4 a0 = acc[ai][bj][m][0], a1 = acc[ai][bj][m][1];
#pragma unroll
                    for (int e = 0; e < 4; ++e) { a0[e] = sigm(a0[e]); a1[e] = sigm(a1[e]); }
                    *(f32x4*)(R + o) = x0 * ALPHA + a0 * p0; *(f32x4*)(R + o + 4) = x1 * ALPHA + a1 * p1; } }
    }
};
struct EpiA {
    static constexpr bool PERM = true, AFTER_DRAIN = false;
    bf16_t* AB; float* out;
    __device__ __forceinline__ void operator()(const f32x4 (&acc)[2][2][4][2], const Unit& u, int wr, int wc, int fr, int fq) const {
        const int rowb = u.pm * BM + wr * 64 + fr, col0 = u.pn * BM + wc * 32 + 8 * fq;
        const bool sample = u.pm >= 64;
#pragma unroll
        for (int ai = 0; ai < 2; ++ai)
#pragma unroll
            for (int m = 0; m < 4; ++m) { const int row = rowb + ai * HALF + m * 16;
                float* cp = nullptr;
                if (sample) { const int t = row & 7; if (t >= 6) cp = out + OFF_CS + ((size_t)((row - MP) >> 3) * 2 + (t - 6)) * FF; }
                else { const int t = row & 8191; if (t >= 8190) cp = out + OFF_CP + ((size_t)(row >> 13) * 2 + (t - 8190)) * FF; }
#pragma unroll
                for (int bj = 0; bj < 2; ++bj) { const int c = col0 + bj * HALF; const f32x4 v0 = acc[ai][bj][m][0], v1 = acc[ai][bj][m][1];
                    if (cp) { *(f32x4*)(cp + c) = v0; *(f32x4*)(cp + c + 4) = v1; }
                    u32x4 w; w.x = pkbf(v0[0], v0[1]); w.y = pkbf(v0[2], v0[3]); w.z = pkbf(v1[0], v1[1]); w.w = pkbf(v1[2], v1[3]);
                    *(u32x4*)(AB + (size_t)row * FF + c) = w; } }
    }
};
struct EpiU {
    static constexpr bool PERM = true, AFTER_DRAIN = false;
    const bf16_t* AB; const float* cprev; const float* cw; const float* cbias; bf16_t* HM;
    __device__ __forceinline__ void ld8(const bf16_t* p, f32x4& a, f32x4& b) const { const u32x4 w = *(const u32x4*)p; a = (f32x4){bflo(w.x), bfhi(w.x), bflo(w.y), bfhi(w.y)}; b = (f32x4){bflo(w.z), bfhi(w.z), bflo(w.w), bfhi(w.w)}; }
    __device__ __forceinline__ void operator()(const f32x4 (&acc)[2][2][4][2], const Unit& u, int wr, int wc, int fr, int fq) const {
        const int rowb = u.pm * BM + wr * 64 + fr, col0 = u.pn * BM + wc * 32 + 8 * fq;
        const bool sample = u.pm >= 64;
#pragma unroll
        for (int bj = 0; bj < 2; ++bj) {
            const int c = col0 + bj * HALF;
            const f32x4 w0a = *(const f32x4*)(cw + c), w0b = *(const f32x4*)(cw + c + 4), w1a = *(const f32x4*)(cw + FF + c), w1b = *(const f32x4*)(cw + FF + c + 4);
            const f32x4 w2a = *(const f32x4*)(cw + 2 * FF + c), w2b = *(const f32x4*)(cw + 2 * FF + c + 4), cba = *(const f32x4*)(cbias + c), cbb = *(const f32x4*)(cbias + c + 4);
#pragma unroll
            for (int ai = 0; ai < 2; ++ai)
#pragma unroll
                for (int m = 0; m < 4; ++m) { const int row = rowb + ai * HALF + m * 16; const int t = sample ? (row & 7) : (row & 8191);
                    f32x4 a0a, a0b, a1a = {0.f, 0.f, 0.f, 0.f}, a1b = a1a, a2a = a1a, a2b = a1a;
                    ld8(AB + (size_t)row * FF + c, a0a, a0b);
                    if (t >= 1) ld8(AB + (size_t)(row - 1) * FF + c, a1a, a1b);
                    else if (sample) { const float* p = cprev + ((size_t)((row - MP) >> 3) * 2 + 1) * FF + c; a1a = *(const f32x4*)p; a1b = *(const f32x4*)(p + 4); }
                    if (t >= 2) ld8(AB + (size_t)(row - 2) * FF + c, a2a, a2b);
                    else if (sample) { const float* p = cprev + ((size_t)((row - MP) >> 3) * 2 + t) * FF + c; a2a = *(const f32x4*)p; a2b = *(const f32x4*)(p + 4); }
                    const f32x4 ca = cba + w0a * a2a + w1a * a1a + w2a * a0a, cbv = cbb + w0b * a2b + w1b * a1b + w2b * a0b;
                    const f32x2 g0 = gelu_pk((f32x2){ca[0], ca[1]}), g1 = gelu_pk((f32x2){ca[2], ca[3]}), g2 = gelu_pk((f32x2){cbv[0], cbv[1]}), g3 = gelu_pk((f32x2){cbv[2], cbv[3]});
                    const f32x4 u0 = acc[ai][bj][m][0], u1 = acc[ai][bj][m][1];
                    u32x4 w; w.x = pkbf(g0.x * u0[0], g0.y * u0[1]); w.y = pkbf(g1.x * u0[2], g1.y * u0[3]); w.z = pkbf(g2.x * u1[0], g2.y * u1[1]); w.w = pkbf(g3.x * u1[2], g3.y * u1[3]);
                    *(u32x4*)(HM + (size_t)row * FF + c) = w; }
        }
    }
};
}

__device__ const float kRopeInv[32] = {
    1.000000000e+00f, 7.498942614e-01f, 5.623413324e-01f, 4.216965139e-01f, 3.162277639e-01f, 2.371373773e-01f, 1.778279394e-01f, 1.333521307e-01f,
    1.000000015e-01f, 7.498941571e-02f, 5.623413250e-02f, 4.216965288e-02f, 3.162277490e-02f, 2.371373773e-02f, 1.778279431e-02f, 1.333521493e-02f,
    9.999999776e-03f, 7.498941850e-03f, 5.623413250e-03f, 4.216964822e-03f, 3.162277630e-03f, 2.371373586e-03f, 1.778279431e-03f, 1.333521446e-03f,
    1.000000047e-03f, 7.498942432e-04f, 5.623413017e-04f, 4.216965172e-04f, 3.162277571e-04f, 2.371373703e-04f, 1.778279402e-04f, 1.333521504e-04f};

__device__ __forceinline__ int win_dst(int ns) {
    if (ns < 3072) return ns;
    if (ns < 3088) return 9728 + (ns - 3072);
    const int c = ns - 16;
    if (c < 6144) { const int hb = c & ~63, d = c & 63; return hb + 2 * (d & 31) + (d >> 5); }
    return c;
}
template <bool MAPIN>
__device__ __forceinline__ void transpose_item(const float* W, int K, int N, bf16* WT, LAS float* scr, int item, int lane) {
    const int nblk = (N + 31) / 32, kb = item / nblk, nb = item % nblk, k0 = 64 * kb, n0 = 32 * nb;
    const bool okr = (n0 + (lane & 31)) < N;
#pragma unroll 8
    for (int i = 0; i < 32; ++i) { const int kk = 2 * i + (lane >> 5); scr[kk * 33 + (lane & 31)] = okr ? W[(size_t)(k0 + kk) * N + n0 + (lane & 31)] : 0.f; }
    asm volatile("s_waitcnt lgkmcnt(0)" ::: "memory");
    const int c = lane & 7;
#pragma unroll
    for (int j = 0; j < 4; ++j) { const int n = (lane >> 3) + 8 * j; const LAS float* s = scr + (8 * c) * 33 + n;
        u32x4 o; o.x = pkbf(s[0 * 33], s[1 * 33]); o.y = pkbf(s[2 * 33], s[3 * 33]); o.z = pkbf(s[4 * 33], s[5 * 33]); o.w = pkbf(s[6 * 33], s[7 * 33]);
        const int ns = n0 + n;
        if (ns < N) { const int dr = MAPIN ? win_dst(ns) : ns; *(u32x4*)(WT + (size_t)dr * K + k0 + 8 * c) = o; } }
    asm volatile("s_waitcnt lgkmcnt(0)" ::: "memory");
}
__device__ __forceinline__ void row_to_bf16(const float* src, bf16* dst, int ncol, int lane) {
    for (int c = lane * 4; c < ncol; c += 256) { const f32x4 v = *(const f32x4*)(src + c); u32x2 w; w.x = pkbf(v[0], v[1]); w.y = pkbf(v[2], v[3]); *(u32x2*)(dst + c) = w; }
}
__device__ __forceinline__ void ln_pass(const float* R, const float* gam, const float* bet, float* of32, bf16* obf, int gw, int ngw, int lane) {
    f32x4 gv[4], bv[4];
#pragma unroll
    for (int j = 0; j < 4; ++j) { gv[j] = *(const f32x4*)(gam + 4 * lane + 256 * j); bv[j] = *(const f32x4*)(bet + 4 * lane + 256 * j); }
    for (int row = gw; row < MROWS; row += ngw) {
        const float* xr = R + (size_t)row * DM + 4 * lane;
        f32x4 v[4]; float s = 0.f;
#pragma unroll
        for (int j = 0; j < 4; ++j) { v[j] = *(const f32x4*)(xr + 256 * j); s += (v[j][0] + v[j][1]) + (v[j][2] + v[j][3]); }
#pragma unroll
        for (int o = 1; o < 64; o <<= 1) s += __shfl_xor(s, o);
        const float mean = s * (1.f / DM); float s2 = 0.f;
#pragma unroll
        for (int j = 0; j < 4; ++j) { v[j] = v[j] - mean; s2 += (v[j][0] * v[j][0] + v[j][1] * v[j][1]) + (v[j][2] * v[j][2] + v[j][3] * v[j][3]); }
#pragma unroll
        for (int o = 1; o < 64; o <<= 1) s2 += __shfl_xor(s2, o);
        const float rstd = 1.0f / sqrtf(s2 * (1.f / DM) + LN_EPS);
#pragma unroll
        for (int j = 0; j < 4; ++j) { const f32x4 y = v[j] * rstd * gv[j] + bv[j];
            if (of32) *(f32x4*)(of32 + (size_t)row * DM + 4 * lane + 256 * j) = y;
            if (obf) { u32x2 w; w.x = pkbf(y[0], y[1]); w.y = pkbf(y[2], y[3]); *(u32x2*)(obf + (size_t)row * DM + 4 * lane + 256 * j) = w; } }
    }
}

constexpr int AT_PITCH = 144, AT_VOFF = 272 * 144;
__device__ __forceinline__ void attn_softmax(f32x4 (&sc)[5][2], int kbase, int kq, int klo, int khi, int g4, bf16x8 (&pf)[5], float& lsum, float& mx) {
    float m = -INFINITY;
#pragma unroll
    for (int ks = 0; ks < 5; ++ks)
#pragma unroll
        for (int be = 0; be < 2; ++be)
#pragma unroll
            for (int i = 0; i < 4; ++i) { const int key = kbase + 32 * ks + 8 * g4 + 4 * be + i; const bool ok = (key <= kq) && (key + 128 >= kq) && (key >= klo) && (key < khi);
                const float s = ok ? sc[ks][be][i] : -INFINITY; sc[ks][be][i] = s; m = fmaxf(m, s); }
    m = fmaxf(m, __shfl_xor(m, 16)); m = fmaxf(m, __shfl_xor(m, 32));
    float l = 0.f;
#pragma unroll
    for (int ks = 0; ks < 5; ++ks) {
#pragma unroll
        for (int be = 0; be < 2; ++be)
#pragma unroll
            for (int i = 0; i < 4; ++i) { const float p = __builtin_amdgcn_exp2f(sc[ks][be][i] - m); sc[ks][be][i] = p; l += p; }
        pf[ks] = pack8(sc[ks][0], sc[ks][1]);
    }
    l += __shfl_xor(l, 16); l += __shfl_xor(l, 32);
    lsum = l; mx = m;
}

__device__ __forceinline__ void attn_prompt_unit(LAS unsigned char* lds, int unit, const bf16* H, bf16* OAT, float* LSE, int tid, int lane, int wid) {
    const int g = unit >> 10, rem = unit & 1023, b = rem >> 9, rem2 = rem & 511, h = rem2 >> 6, x = rem2 & 63;
    const int sh = 2 * g, r = 1 << sh;
    const int nqb = 64 >> sh;
    const int c = x / nqb, qb = x % nqb;
    const int rowbase = b * TP;
    const int jk0 = 128 * qb - 128;
    const int colk = C_DK + g * 512 + h * 64, colv = C_DV + g * 512 + h * 64, colq = C_DQ + g * 512 + h * 64;
#pragma unroll
    for (int i = 0; i < 8; ++i) {
        const int p = tid + 512 * i, kv = p >> 11, rr = (p & 2047) >> 3, pc = p & 7;
        const int jk = jk0 + rr;
        u32x4 val = {0u, 0u, 0u, 0u};
        if (jk >= 0) val = *(const u32x4*)(H + (size_t)(rowbase + jk * r + c) * HLD + (kv ? colv : colk) + pc * 8);
        *(LAS u32x4*)(lds + (kv ? AT_VOFF : 0) + rr * AT_PITCH + pc * 16) = val;
    }
    if (tid < 256) { const int kv = tid >> 7, rr = 256 + ((tid & 127) >> 3), pc = tid & 7; *(LAS u32x4*)(lds + (kv ? AT_VOFF : 0) + rr * AT_PITCH + pc * 16) = (u32x4){0u, 0u, 0u, 0u}; }
    __syncthreads();
    {
        const int fr = lane & 15, g4 = lane >> 4;
        const int jq = 128 * qb + 16 * wid + fr;
        const size_t qrow = (size_t)(rowbase + jq * r + c);
        const bf16* qp = H + qrow * HLD + colq + 8 * g4;
        const bf16x8 qf0 = *(const bf16x8*)qp, qf1 = *(const bf16x8*)(qp + 32);
        f32x4 sc[5][2];
#pragma unroll
        for (int ks = 0; ks < 5; ++ks)
#pragma unroll
            for (int be = 0; be < 2; ++be) {
                const int krow = 16 * wid + 32 * ks + 8 * (fr >> 2) + 4 * be + (fr & 3);
                const LAS unsigned char* kp = lds + krow * AT_PITCH + 16 * g4;
                const bf16x8 k0 = *(const LAS bf16x8*)kp, k1 = *(const LAS bf16x8*)(kp + 64);
                f32x4 a = {0.f, 0.f, 0.f, 0.f}; a = MFMA16(k0, qf0, a); a = MFMA16(k1, qf1, a); sc[ks][be] = a;
            }
        bf16x8 pf[5]; float l, mx;
        attn_softmax(sc, 16 * wid, 128 + 16 * wid + fr, (qb == 0) ? 128 : 0, 256, g4, pf, l, mx);
        f32x4 oT[4];
#pragma unroll
        for (int db = 0; db < 4; ++db) { oT[db] = (f32x4){0.f, 0.f, 0.f, 0.f};
#pragma unroll
            for (int ks = 0; ks < 5; ++ks) { const bf16x8 vf = ld_tr(lds + AT_VOFF, AT_PITCH, 16 * wid + 32 * ks, 32 * db, lane); oT[db] = MFMA16(vf, pf[ks], oT[db]); } }
        const float il = 1.0f / l;
        bf16* op = OAT + ((size_t)g * MROWS + qrow) * 512 + h * 64 + 4 * g4;
#pragma unroll
        for (int db = 0; db < 4; ++db) { u32x2 w; w.x = pkbf(oT[db][0] * il, oT[db][1] * il); w.y = pkbf(oT[db][2] * il, oT[db][3] * il); *(u32x2*)(op + 16 * db) = w; }
        if (g4 == 0) LSE[((size_t)g * MROWS + qrow) * 8 + h] = mx + __log2f(l);
    }
    __syncthreads();
}

__device__ __forceinline__ void attn_dec_unit(LAS unsigned char* lds, int unit, const float* ck0, const float* ck1, const float* ck2, const bf16* H, bf16* OAT, float* LSE, int lane, int wid) {
    int g, b, c;
    if (unit < 128) { g = 0; b = unit; c = 0; } else if (unit < 640) { g = 1; b = (unit - 128) >> 2; c = (unit - 128) & 3; } else { g = 2; b = (unit - 640) >> 3; c = (unit - 640) & 7; }
    const int sh = 2 * g, r = 1 << sh, W = 128 << sh, nnew = 8 >> (g == 0 ? 0 : g == 1 ? 2 : 3);
    const int h = wid, fr = lane & 15, g4 = lane >> 4;
    const float* cache = ((g == 0) ? ck0 : (g == 1) ? ck1 : ck2) + (size_t)b * W * 1024 + h * 64;
    const size_t nrow0 = (size_t)MP + 8 * b;
    const int colk = C_DK + g * 512 + h * 64, colv = C_DV + g * 512 + h * 64, colq = C_DQ + g * 512 + h * 64;
    LAS unsigned char* wl = lds + wid * (32 * AT_PITCH);
    const int qi = fr < nnew ? fr : nnew - 1;
    const bf16* qp = H + (nrow0 + c + r * qi) * HLD + colq + 8 * g4;
    const bf16x8 qf0 = *(const bf16x8*)qp, qf1 = *(const bf16x8*)(qp + 32);
    f32x4 sc[5][2];
#pragma unroll
    for (int ks = 0; ks < 4; ++ks)
#pragma unroll
        for (int be = 0; be < 2; ++be) {
            const int key = 32 * ks + 8 * (fr >> 2) + 4 * be + (fr & 3);
            const float* kp = cache + (size_t)(c + r * key) * 1024 + 4 * g4;
            const f32x4 lo0 = *(const f32x4*)kp, hi0 = *(const f32x4*)(kp + 32), lo1 = *(const f32x4*)(kp + 16), hi1 = *(const f32x4*)(kp + 48);
            u32x4 w0, w1;
            w0.x = pkbf(lo0[0], hi0[0]); w0.y = pkbf(lo0[1], hi0[1]); w0.z = pkbf(lo0[2], hi0[2]); w0.w = pkbf(lo0[3], hi0[3]);
            w1.x = pkbf(lo1[0], hi1[0]); w1.y = pkbf(lo1[1], hi1[1]); w1.z = pkbf(lo1[2], hi1[2]); w1.w = pkbf(lo1[3], hi1[3]);
            f32x4 a = {0.f, 0.f, 0.f, 0.f}; a = MFMA16(__builtin_bit_cast(bf16x8, w0), qf0, a); a = MFMA16(__builtin_bit_cast(bf16x8, w1), qf1, a); sc[ks][be] = a;
        }
#pragma unroll
    for (int be = 0; be < 2; ++be) {
        const int i = 8 * (fr >> 2) + 4 * be + (fr & 3);
        bf16x8 k0 = {0, 0, 0, 0, 0, 0, 0, 0}, k1 = k0;
        if (i < nnew) { const bf16* kp = H + (nrow0 + c + r * i) * HLD + colk + 8 * g4; k0 = *(const bf16x8*)kp; k1 = *(const bf16x8*)(kp + 32); }
        f32x4 a = {0.f, 0.f, 0.f, 0.f}; a = MFMA16(k0, qf0, a); a = MFMA16(k1, qf1, a); sc[4][be] = a;
    }
    bf16x8 pf[5]; float l, mx;
    attn_softmax(sc, 0, 128 + fr, 0, 128 + nnew, g4, pf, l, mx);
    f32x4 oT[4];
#pragma unroll
    for (int db = 0; db < 4; ++db) oT[db] = (f32x4){0.f, 0.f, 0.f, 0.f};
#pragma unroll
    for (int ks = 0; ks < 5; ++ks) {
        if (ks < 4) {
#pragma unroll
            for (int i = 0; i < 8; ++i) { const int rr = 4 * i + g4; const f32x4 v = *(const f32x4*)(cache + (size_t)(c + r * (32 * ks + rr)) * 1024 + 512 + 4 * fr);
                u32x2 w; w.x = pkbf(v[0], v[1]); w.y = pkbf(v[2], v[3]); *(LAS u32x2*)(wl + rr * AT_PITCH + fr * 8) = w; }
        } else {
#pragma unroll
            for (int i = 0; i < 4; ++i) { const int rr = 8 * i + (lane >> 3), pc = lane & 7; u32x4 val = {0u, 0u, 0u, 0u};
                if (rr < nnew) val = *(const u32x4*)(H + (nrow0 + c + r * rr) * HLD + colv + pc * 8);
                *(LAS u32x4*)(wl + rr * AT_PITCH + pc * 16) = val; }
        }
#pragma unroll
        for (int db = 0; db < 4; ++db) { const bf16x8 vf = ld_tr(wl, AT_PITCH, 0, 32 * db, lane); oT[db] = MFMA16(vf, pf[ks], oT[db]); }
    }
    if (fr < nnew) {
        const float il = 1.0f / l;
        const size_t qrow = nrow0 + c + r * fr;
        bf16* op = OAT + ((size_t)g * MROWS + qrow) * 512 + h * 64 + 4 * g4;
#pragma unroll
        for (int db = 0; db < 4; ++db) { u32x2 w; w.x = pkbf(oT[db][0] * il, oT[db][1] * il); w.y = pkbf(oT[db][2] * il, oT[db][3] * il); *(u32x2*)(op + 16 * db) = w; }
        if (g4 == 0) LSE[((size_t)g * MROWS + qrow) * 8 + h] = mx + __log2f(l);
    }
}

constexpr int G1_GLR = 0, G1_PART = 4096, G1_DEC = 6144, G1_K = 8192, G1_KP = 272, G1_V = 8192 + 64 * 272, G1_VP = 528;
__device__ __forceinline__ void g1_unit(LAS unsigned char* lds, int unit, const bf16* H, const float* GLR, const float* wgk, const float* bgk, float* LBUF, float* DC, int tid, int lane, int wid) {
    const int bh = unit >> 5, cch = unit & 31, b = bh >> 2, h = bh & 3;
    const int row0 = b * TP + cch * 256;
    const int ch = tid & 127, sq = tid >> 7;
    float w[16];
#pragma unroll
    for (int r = 0; r < 16; ++r) w[r] = wgk[r * 512 + h * 128 + ch];
    const float bias = bgk[h * 128 + ch];
    f32x4 acc[2][8];
#pragma unroll
    for (int vb = 0; vb < 2; ++vb)
#pragma unroll
        for (int kb = 0; kb < 8; ++kb) acc[vb][kb] = (f32x4){0.f, 0.f, 0.f, 0.f};
    float btot = 0.f;
    for (int j = 0; j < 4; ++j) {
        const int rj = row0 + 64 * j;
        if (tid < 256) *(LAS f32x4*)(lds + G1_GLR + tid * 16) = *(const f32x4*)(GLR + (size_t)rj * 16 + tid * 4);
#pragma unroll
        for (int i = 0; i < 4; ++i) { const int p = tid + 512 * i, rr = p >> 5, pc = p & 31;
            *(LAS u32x4*)(lds + G1_V + rr * G1_VP + pc * 16) = *(const u32x4*)(H + (size_t)(rj + rr) * HLD + C_GV + h * 256 + pc * 8); }
        __syncthreads();
        float ld[16]; float loc = 0.f;
#pragma unroll
        for (int i = 0; i < 16; ++i) {
            const LAS f32x4* gp = (const LAS f32x4*)(lds + G1_GLR + (16 * sq + i) * 64);
            const f32x4 a0 = gp[0], a1 = gp[1], a2 = gp[2], a3 = gp[3];
            float z = bias;
#pragma unroll
            for (int e = 0; e < 4; ++e) { z += a0[e] * w[e]; z += a1[e] * w[4 + e]; z += a2[e] * w[8 + e]; z += a3[e] * w[12 + e]; }
            ld[i] = logsig16(z); loc += ld[i];
        }
        *(LAS float*)(lds + G1_PART + (sq * 128 + ch) * 4) = loc;
        __syncthreads();
        const float p0 = *(const LAS float*)(lds + G1_PART + ch * 4), p1 = *(const LAS float*)(lds + G1_PART + (128 + ch) * 4);
        const float p2 = *(const LAS float*)(lds + G1_PART + (256 + ch) * 4), p3 = *(const LAS float*)(lds + G1_PART + (384 + ch) * 4);
        const float tot = (p0 + p1) + (p2 + p3);
        float bb = (sq > 0 ? p0 : 0.f) + (sq > 1 ? p1 : 0.f) + (sq > 2 ? p2 : 0.f);
#pragma unroll
        for (int i = 0; i < 16; ++i) {
            bb += ld[i];
            const float kv = bf2f(H[(size_t)(rj + 16 * sq + i) * HLD + C_GK + h * 128 + ch]);
            *(LAS bf16*)(lds + G1_K + (16 * sq + i) * G1_KP + ch * 2) = f2bf(kv * __expf(tot - bb));
        }
        if (sq == 0) *(LAS float*)(lds + G1_DEC + ch * 4) = __expf(tot);
        btot += tot;
        __syncthreads();
        if (j > 0) {
#pragma unroll
            for (int kb = 0; kb < 8; ++kb) { const float d = *(const LAS float*)(lds + G1_DEC + (16 * kb + (lane & 15)) * 4);
#pragma unroll
                for (int vb = 0; vb < 2; ++vb) acc[vb][kb] = acc[vb][kb] * d; }
        }
#pragma unroll
        for (int s2 = 0; s2 < 2; ++s2) {
            bf16x8 af[2];
#pragma unroll
            for (int vb = 0; vb < 2; ++vb) af[vb] = ld_tr(lds + G1_V, G1_VP, 32 * s2, (32 * wid + 16 * vb) * 2, lane);
#pragma unroll
            for (int kb = 0; kb < 8; ++kb) { const bf16x8 bfr = ld_tr(lds + G1_K, G1_KP, 32 * s2, 32 * kb, lane);
#pragma unroll
                for (int vb = 0; vb < 2; ++vb) acc[vb][kb] = MFMA16(af[vb], bfr, acc[vb][kb]); }
        }
        __syncthreads();
    }
    float* lb = LBUF + (size_t)unit * 256 * 128;
#pragma unroll
    for (int vb = 0; vb < 2; ++vb)
#pragma unroll
        for (int kb = 0; kb < 8; ++kb)
#pragma unroll
            for (int i = 0; i < 4; ++i) lb[(size_t)(32 * wid + 16 * vb + 4 * (lane >> 4) + i) * 128 + 16 * kb + (lane & 15)] = acc[vb][kb][i];
    if (sq == 0) DC[unit * 128 + ch] = __expf(btot);
}

constexpr int GS_COEF = 0, GS_QB = 12288, GS_KB = 16384, GS_A = 20480, GS_VV = 20736, GS_OP = 28928, GS_RED = 45312;
__device__ __forceinline__ void gla_sample_unit(LAS unsigned char* lds, int unit, const bf16* H, const float* GLR, const float* wgk, const float* bgk, const float* state, const float* gnorm,
                                                float* out, bf16* OG, int tid, int lane, int wid) {
    const int b = unit >> 2, h = unit & 3;
    const size_t row0 = (size_t)MP + 8 * b;
    LAS float* coef = (LAS float*)(lds + GS_COEF);
    LAS float* qb = (LAS float*)(lds + GS_QB);
    LAS float* kb = (LAS float*)(lds + GS_KB);
    LAS float* Am = (LAS float*)(lds + GS_A);
    LAS float* vv = (LAS float*)(lds + GS_VV);
    LAS float* op = (LAS float*)(lds + GS_OP);
    LAS float* red = (LAS float*)(lds + GS_RED);
    if (tid < 128) {
        const int ch = tid;
        float bt[8]; float bc = 0.f;
        const float bias = bgk[h * 128 + ch];
        float w[16];
#pragma unroll
        for (int r = 0; r < 16; ++r) w[r] = wgk[r * 512 + h * 128 + ch];
#pragma unroll
        for (int t = 0; t < 8; ++t) { const float* gp = GLR + (row0 + t) * 16; float z = bias;
#pragma unroll
            for (int r = 0; r < 16; ++r) z += gp[r] * w[r];
            bc += logsig16(z); bt[t] = bc; }
#pragma unroll
        for (int t = 0; t < 8; ++t) {
            const float qv = bf2f(H[(row0 + t) * HLD + C_GQ + h * 128 + ch]), kv = bf2f(H[(row0 + t) * HLD + C_GK + h * 128 + ch]);
            const float e = __expf(bt[t]);
            coef[ch * 24 + t] = qv * e; coef[ch * 24 + 8 + t] = kv * __expf(bt[7] - bt[t]);
            qb[t * 128 + ch] = qv * e; kb[t * 128 + ch] = kv * __expf(-bt[t]);
        }
        coef[ch * 24 + 16] = __expf(bt[7]);
    }
#pragma unroll
    for (int i = 0; i < 4; ++i) { const int idx = tid + 512 * i, s = idx >> 8, v = idx & 255; vv[idx] = bf2f(H[(row0 + s) * HLD + C_GV + h * 256 + v]); }
    __syncthreads();
    if (tid < 64) { const int t = tid >> 3, s = tid & 7; float a = 0.f;
        if (s <= t) for (int k = 0; k < 128; ++k) a += qb[t * 128 + k] * kb[s * 128 + k];
        Am[tid] = a; }
    {
        const int v = tid & 255, kh = tid >> 8;
        float o[8], vs[8];
#pragma unroll
        for (int t = 0; t < 8; ++t) { o[t] = 0.f; vs[t] = vv[t * 256 + v]; }
        const float* S0 = state + ((size_t)(b * 4 + h) * 128) * 256 + v;
        float* S1 = out + OFF_GSS + ((size_t)(b * 4 + h) * 128) * 256 + v;
#pragma unroll 4
        for (int kk = 0; kk < 64; ++kk) {
            const int k = kh * 64 + kk;
            const float s0 = S0[(size_t)k * 256];
            const LAS f32x4* cp = (const LAS f32x4*)(coef + k * 24);
            const f32x4 c0 = cp[0], c1 = cp[1], c2 = cp[2], c3 = cp[3]; const float d7 = coef[k * 24 + 16];
            o[0] += c0[0] * s0; o[1] += c0[1] * s0; o[2] += c0[2] * s0; o[3] += c0[3] * s0; o[4] += c1[0] * s0; o[5] += c1[1] * s0; o[6] += c1[2] * s0; o[7] += c1[3] * s0;
            float sn = d7 * s0;
            sn += c2[0] * vs[0]; sn += c2[1] * vs[1]; sn += c2[2] * vs[2]; sn += c2[3] * vs[3]; sn += c3[0] * vs[4]; sn += c3[1] * vs[5]; sn += c3[2] * vs[6]; sn += c3[3] * vs[7];
            S1[(size_t)k * 256] = sn;
        }
#pragma unroll
        for (int t = 0; t < 8; ++t) op[(kh * 8 + t) * 256 + v] = o[t];
    }
    __syncthreads();
    float o[8];
    {
        const int v = tid & 255;
#pragma unroll
        for (int t = 0; t < 8; ++t) { float a = op[t * 256 + v] + op[(8 + t) * 256 + v];
#pragma unroll
            for (int s = 0; s < 8; ++s) if (s <= t) a += Am[t * 8 + s] * vv[s * 256 + v];
            o[t] = a; }
        if (tid < 256) {
#pragma unroll
            for (int t = 0; t < 8; ++t) { float q = o[t] * o[t];
#pragma unroll
                for (int of = 1; of < 64; of <<= 1) q += __shfl_xor(q, of);
                if (lane == 0) red[wid * 8 + t] = q; }
        }
    }
    __syncthreads();
    if (tid < 256) {
        const int v = tid;
        const float gn = gnorm[v];
#pragma unroll
        for (int t = 0; t < 8; ++t) {
            const float ss = (red[t] + red[8 + t]) + (red[16 + t] + red[24 + t]);
            const float rs = 1.0f / sqrtf(ss * (1.f / 256.f) + LN_EPS);
            const float gg = bf2f(H[(row0 + t) * HLD + C_GG + h * 256 + v]);
            OG[(row0 + t) * DM + h * 256 + v] = f2bf(o[t] * rs * gn * gg);
        }
    }
    __syncthreads();
}

constexpr int G3_R0 = 0, G3_R1 = 69632, G3_P = 272, G3_GLR = 139264, G3_PART = 155648, G3_VP = 528;
__device__ __forceinline__ void g3_unit(LAS unsigned char* lds, int unit, const bf16* H, const float* GLR, const float* wgk, const float* bgk, const bf16* SBUF, const float* gnorm, bf16* OG,
                                        int tid, int lane, int wid) {
    const int bh = unit >> 5, cch = unit & 31, b = bh >> 2, h = bh & 3;
    const int row0 = b * TP + cch * 256;
    const int ch = tid & 127, qt = tid >> 7;
#pragma unroll
    for (int i = 0; i < 2; ++i) { const int idx = tid + 512 * i; *(LAS f32x4*)(lds + G3_GLR + idx * 16) = *(const f32x4*)(GLR + (size_t)row0 * 16 + idx * 4); }
    float w[16];
#pragma unroll
    for (int r = 0; r < 16; ++r) w[r] = wgk[r * 512 + h * 128 + ch];
    const float bias = bgk[h * 128 + ch];
    __syncthreads();
    float loc = 0.f;
#pragma unroll 4
    for (int i = 0; i < 64; ++i) {
        const LAS f32x4* gp = (const LAS f32x4*)(lds + G3_GLR + (64 * qt + i) * 64);
        const f32x4 a0 = gp[0], a1 = gp[1], a2 = gp[2], a3 = gp[3];
        float z = bias;
#pragma unroll
        for (int e = 0; e < 4; ++e) { z += a0[e] * w[e]; z += a1[e] * w[4 + e]; z += a2[e] * w[8 + e]; z += a3[e] * w[12 + e]; }
        loc += logsig16(z);
    }
    *(LAS float*)(lds + G3_PART + (qt * 128 + ch) * 4) = loc;
    __syncthreads();
    {
        const float p0 = *(const LAS float*)(lds + G3_PART + ch * 4), p1 = *(const LAS float*)(lds + G3_PART + (128 + ch) * 4), p2 = *(const LAS float*)(lds + G3_PART + (256 + ch) * 4);
        float bb = (qt > 0 ? p0 : 0.f) + (qt > 1 ? p1 : 0.f) + (qt > 2 ? p2 : 0.f);
#pragma unroll 4
        for (int i = 0; i < 64; ++i) {
            const LAS f32x4* gp = (const LAS f32x4*)(lds + G3_GLR + (64 * qt + i) * 64);
            const f32x4 a0 = gp[0], a1 = gp[1], a2 = gp[2], a3 = gp[3];
            float z = bias;
#pragma unroll
            for (int e = 0; e < 4; ++e) { z += a0[e] * w[e]; z += a1[e] * w[4 + e]; z += a2[e] * w[8 + e]; z += a3[e] * w[12 + e]; }
            bb += logsig16(z);
            const size_t rr = (size_t)(row0 + 64 * qt + i) * HLD + h * 128 + ch;
            const float qv = bf2f(H[rr + C_GQ]), kv = bf2f(H[rr + C_GK]);
            *(LAS bf16*)(lds + G3_R0 + (64 * qt + i) * G3_P + ch * 2) = f2bf(qv * __expf(bb));
            *(LAS bf16*)(lds + G3_R1 + (64 * qt + i) * G3_P + ch * 2) = f2bf(kv * __expf(-bb));
        }
    }
    __syncthreads();
    const int fr = lane & 15, g4 = lane >> 4;
    const int tb0 = wid, tb1 = 15 - wid;
    bf16x8 qf[2][4];
#pragma unroll
    for (int ks = 0; ks < 4; ++ks) {
        qf[0][ks] = *(const LAS bf16x8*)(lds + G3_R0 + (16 * tb0 + fr) * G3_P + (32 * ks + 8 * g4) * 2);
        qf[1][ks] = *(const LAS bf16x8*)(lds + G3_R0 + (16 * tb1 + fr) * G3_P + (32 * ks + 8 * g4) * 2);
    }
    __syncthreads();
#pragma unroll 1
    for (int x = 0; x < 2; ++x) {
        const int tb = x ? tb1 : tb0;
#pragma unroll
        for (int i = 0; i < 8; ++i) { const int p = tid + 512 * i, rr = p >> 4, pc = p & 15;
            *(LAS u32x4*)(lds + G3_R0 + rr * G3_P + pc * 16) = *(const u32x4*)(SBUF + ((size_t)unit * 256 + rr) * 128 + pc * 8); }
        __syncthreads();
        bf16x8 qx[4];
#pragma unroll
        for (int ks = 0; ks < 4; ++ks) qx[ks] = x ? qf[1][ks] : qf[0][ks];
        f32x4 oT[16];
#pragma unroll
        for (int vb = 0; vb < 16; ++vb) oT[vb] = (f32x4){0.f, 0.f, 0.f, 0.f};
#pragma unroll
        for (int vb = 0; vb < 16; ++vb)
#pragma unroll
            for (int ks = 0; ks < 4; ++ks) { const bf16x8 sf = *(const LAS bf16x8*)(lds + G3_R0 + (16 * vb + fr) * G3_P + (32 * ks + 8 * g4) * 2);
                oT[vb] = MFMA16(sf, qx[ks], oT[vb]); }
        __syncthreads();
        const int jmax = x ? 3 : 1;
#pragma unroll 1
        for (int j = 0; j <= jmax; ++j) {
#pragma unroll
            for (int i = 0; i < 4; ++i) { const int p = tid + 512 * i, rr = p >> 5, pc = p & 31;
                *(LAS u32x4*)(lds + G3_R0 + rr * G3_VP + pc * 16) = *(const u32x4*)(H + (size_t)(row0 + 64 * j + rr) * HLD + C_GV + h * 256 + pc * 8); }
            __syncthreads();
            if ((tb >> 2) >= j) {
#pragma unroll
                for (int ks2 = 0; ks2 < 2; ++ks2) {
                    f32x4 aT[2];
#pragma unroll
                    for (int be = 0; be < 2; ++be) {
                        aT[be] = (f32x4){0.f, 0.f, 0.f, 0.f};
                        const int srow = 64 * j + 32 * ks2 + 8 * (fr >> 2) + 4 * be + (fr & 3);
#pragma unroll
                        for (int ks = 0; ks < 4; ++ks) { const bf16x8 kf = *(const LAS bf16x8*)(lds + G3_R1 + srow * G3_P + (32 * ks + 8 * g4) * 2); aT[be] = MFMA16(kf, qx[ks], aT[be]); }
                    }
                    if ((tb >> 2) == j) {
#pragma unroll
                        for (int be = 0; be < 2; ++be)
#pragma unroll
                            for (int i = 0; i < 4; ++i) if (32 * ks2 + 8 * g4 + 4 * be + i > 16 * (tb & 3) + fr) aT[be][i] = 0.f;
                    }
                    const bf16x8 pfx = pack8(aT[0], aT[1]);
#pragma unroll
                    for (int vb = 0; vb < 16; ++vb) { const bf16x8 vf = ld_tr(lds + G3_R0, G3_VP, 32 * ks2, 32 * vb, lane); oT[vb] = MFMA16(vf, pfx, oT[vb]); }
                }
            }
            __syncthreads();
        }
        {
            const int t = 16 * tb + fr; const size_t row = (size_t)row0 + t;
            float ss = 0.f;
#pragma unroll
            for (int vb = 0; vb < 16; ++vb)
#pragma unroll
                for (int i = 0; i < 4; ++i) ss += oT[vb][i] * oT[vb][i];
            ss += __shfl_xor(ss, 16); ss += __shfl_xor(ss, 32);
            const float rs = 1.0f / sqrtf(ss * (1.f / 256.f) + LN_EPS);
#pragma unroll
            for (int vb = 0; vb < 16; ++vb) { const int v = 16 * vb + 4 * g4; const f32x4 gn = *(const f32x4*)(gnorm + v);
                const u32x2 gw = *(const u32x2*)(H + row * HLD + C_GG + h * 256 + v);
                const f32x4 o = oT[vb] * rs * gn * (f32x4){bflo(gw.x), bfhi(gw.x), bflo(gw.y), bfhi(gw.y)};
                u32x2 wv; wv.x = pkbf(o[0], o[1]); wv.y = pkbf(o[2], o[3]); *(u32x2*)(OG + row * DM + h * 256 + v) = wv; }
        }
    }
}

constexpr int LDS_TAB = LDS_MISC + 16;
template <class T> __device__ __forceinline__ T* ldp(const LAS unsigned char* lds, int i) {
    const LAS unsigned* t = (const LAS unsigned*)(lds + LDS_TAB) + 2 * i;
    const unsigned lo = __builtin_amdgcn_readfirstlane(t[0]), hi = __builtin_amdgcn_readfirstlane(t[1]);
    return (T*)(GAS T*)(((unsigned long long)hi << 32) | lo);
}
struct Args { const float* in[28]; float* outp; unsigned char* wsp; int ph_lo, ph_hi; };
constexpr int N_PHASES = 14;
#define x_prompt (ldp<const float>(lds, 0))
#define x_sample (ldp<const float>(lds, 1))
#define p_prompt (ldp<const float>(lds, 2))
#define p_sample (ldp<const float>(lds, 3))
#define state_gla (ldp<const float>(lds, 4))
#define cache_conv (ldp<const float>(lds, 5))
#define ck0 (ldp<const float>(lds, 6))
#define ck1 (ldp<const float>(lds, 7))
#define ck2 (ldp<const float>(lds, 8))
#define w_in (ldp<const float>(lds, 9))
#define w_gk_b (ldp<const float>(lds, 10))
#define b_gk (ldp<const float>(lds, 11))
#define gla_norm (ldp<const float>(lds, 12))
#define w_br_gla (ldp<const float>(lds, 13))
#define w_br_dil (ldp<const float>(lds, 14))
#define w_out (ldp<const float>(lds, 15))
#define ln1_g (ldp<const float>(lds, 16))
#define ln1_b (ldp<const float>(lds, 17))
#define w_up (ldp<const float>(lds, 18))
#define conv_w (ldp<const float>(lds, 19))
#define conv_b (ldp<const float>(lds, 20))
#define w_down (ldp<const float>(lds, 21))
#define ln2_g (ldp<const float>(lds, 22))
#define ln2_b (ldp<const float>(lds, 23))
#define w_ple_gate (ldp<const float>(lds, 24))
#define w_ple_proj (ldp<const float>(lds, 25))
#define ln3_g (ldp<const float>(lds, 26))
#define ln3_b (ldp<const float>(lds, 27))
#define RCOS ((float*)(ldp<unsigned char>(lds, 29) + WS_RCOS))
#define RSIN ((float*)(ldp<unsigned char>(lds, 29) + WS_RSIN))
#define BIN ((bf16*)(ldp<unsigned char>(lds, 29) + WS_BIN))
#define BBG ((bf16*)(ldp<unsigned char>(lds, 29) + WS_BBG))
#define BBD ((bf16*)(ldp<unsigned char>(lds, 29) + WS_BBD))
#define BOUT ((bf16*)(ldp<unsigned char>(lds, 29) + WS_BOUT))
#define BUP ((bf16*)(ldp<unsigned char>(lds, 29) + WS_BUP))
#define BDN ((bf16*)(ldp<unsigned char>(lds, 29) + WS_BDN))
#define BPG ((bf16*)(ldp<unsigned char>(lds, 29) + WS_BPG))
#define BPP ((bf16*)(ldp<unsigned char>(lds, 29) + WS_BPP))
#define XB ((bf16*)(ldp<unsigned char>(lds, 29) + WS_XB))
#define PEB ((bf16*)(ldp<unsigned char>(lds, 29) + WS_PEB))
#define GLR ((float*)(ldp<unsigned char>(lds, 29) + WS_GLR))
#define DC ((float*)(ldp<unsigned char>(lds, 29) + WS_DC))
#define LSE ((float*)(ldp<unsigned char>(lds, 29) + WS_LSE))
#define H ((bf16*)(ldp<unsigned char>(lds, 29) + WS_H))
#define LBUF ((float*)(ldp<unsigned char>(lds, 29) + WS_LBUF))
#define SBUF ((bf16*)(ldp<unsigned char>(lds, 29) + WS_SBUF))
#define OAT ((bf16*)(ldp<unsigned char>(lds, 29) + WS_OAT))
#define OD ((bf16*)(ldp<unsigned char>(lds, 29) + WS_OD))
#define OG ((bf16*)(ldp<unsigned char>(lds, 29) + WS_OG))
#define T ((float*)(ldp<unsigned char>(lds, 29) + WS_T))
#define MB ((bf16*)(ldp<unsigned char>(lds, 29) + WS_MB))
#define R ((float*)(ldp<unsigned char>(lds, 29) + WS_R))
#define X1 ((float*)(ldp<unsigned char>(lds, 29) + WS_X1))
#define X1B ((bf16*)(ldp<unsigned char>(lds, 29) + WS_X1B))
#define AB ((bf16*)(ldp<unsigned char>(lds, 29) + WS_AB))
#define HM ((bf16*)(ldp<unsigned char>(lds, 29) + WS_HM))
#define X2 ((float*)(ldp<unsigned char>(lds, 29) + WS_X2))
#define X2B ((bf16*)(ldp<unsigned char>(lds, 29) + WS_X2B))
#define PP ((float*)(ldp<unsigned char>(lds, 29) + WS_PP))
#define out (ldp<float>(lds, 28))

__global__ void __launch_bounds__(NTHREADS, 2) mk_fwd(Args args) {
    extern __shared__ __attribute__((aligned(16))) unsigned char lds_raw[];
    LAS unsigned char* lds = (LAS unsigned char*)lds_raw;
    const int tid = threadIdx.x, lane = tid & 63, wid = __builtin_amdgcn_readfirstlane(tid >> 6);
    const int G = gridDim.x, bx = blockIdx.x;
    const int gw = bx * NWAVES + wid, NGW = G * NWAVES;
    const int gt = bx * NTHREADS + tid, NGT = G * NTHREADS;
    if (tid < 4) ((LAS unsigned*)(lds + LDS_MISC))[tid] = 0u;
    if (tid == 0) {
        LAS unsigned long long* tab = (LAS unsigned long long*)(lds + LDS_TAB);
#pragma unroll
        for (int i = 0; i < 28; ++i) tab[i] = (unsigned long long)args.in[i];
        tab[28] = (unsigned long long)args.outp; tab[29] = (unsigned long long)args.wsp;
    }
    __syncthreads();
    unsigned* ctl = (unsigned*)(ldp<unsigned char>(lds, 29) + WS_CTL);
    const int lo = args.ph_lo, hi = args.ph_hi;
    const bool multi = (hi - lo) > 1;
    XcdBarrier bar; bar.bar = ctl + CW_BAR; bar.x = 0; bar.st = nullptr;
    if (multi) bar = xcd_barrier_post(ctl + CW_BAR, (volatile LAS unsigned*)(lds + LDS_MISC));
#ifndef PHMASK
#define PHMASK 0xffffffffu
#endif
#define IN(k) (((PHMASK >> (k)) & 1u) && lo <= (k) && (k) < hi)
#define SEAM(k) do { if (IN(k) && IN((k) + 1)) xcd_barrier(bar); } while (0)

    if (IN(0)) {
        LAS float* scr = (LAS float*)(lds + wid * 16384);
        constexpr int I_IN = 16 * 305, I_BG = 16 * 32, I_BD = 8 * 32, I_OUT = 16 * 32, I_UP = 16 * 176, I_DN = 44 * 32, I_PG = 16 * 32, I_PP = 4 * 32;
        constexpr int NITEMS = I_IN + I_BG + I_BD + I_OUT + I_UP + I_DN + I_PG + I_PP;
        for (int it = gw; it < NITEMS; it += NGW) {
            int r = it;
            if (r < I_IN) { transpose_item<true>(w_in, 1024, 9744, BIN, scr, r, lane); continue; } r -= I_IN;
            if (r < I_BG) { transpose_item<false>(w_br_gla, 1024, 1024, BBG, scr, r, lane); continue; } r -= I_BG;
            if (r < I_BD) { transpose_item<false>(w_br_dil, 512, 1024, BBD, scr, r, lane); continue; } r -= I_BD;
            if (r < I_OUT) { transpose_item<false>(w_out, 1024, 1024, BOUT, scr, r, lane); continue; } r -= I_OUT;
            if (r < I_UP) { transpose_item<false>(w_up, 1024, 5632, BUP, scr, r, lane); continue; } r -= I_UP;
            if (r < I_DN) { transpose_item<false>(w_down, 2816, 1024, BDN, scr, r, lane); continue; } r -= I_DN;
            if (r < I_PG) { transpose_item<false>(w_ple_gate, 1024, 1024, BPG, scr, r, lane); continue; } r -= I_PG;
            transpose_item<false>(w_ple_proj, 256, 1024, BPP, scr, r, lane);
        }
        for (int i = gt; i < 240 * 128; i += NGT) *(u32x4*)(BIN + (size_t)9744 * 1024 + (size_t)i * 8) = (u32x4){0u, 0u, 0u, 0u};
        for (int m = gw; m < MROWS; m += NGW) {
            const float* xs = (m < MP) ? x_prompt + (size_t)m * DM : x_sample + (size_t)(m - MP) * DM;
            row_to_bf16(xs, XB + (size_t)m * DM, DM, lane);
            const float* ps = (m < MP) ? p_prompt + (size_t)m * 256 : p_sample + (size_t)(m - MP) * 256;
            row_to_bf16(ps, PEB + (size_t)m * 256, 256, lane);
        }
        for (int idx = gt; idx < 8200 * 32; idx += NGT) {
            const int pos = idx >> 5, i = idx & 31;
            const float a32 = (float)pos * kRopeInv[i];
            const double a = (double)a32;
            const double n = rint(a * 0.15915494309189535);
            double rr = fma(-n, 6.283185307179586, a); rr = fma(-n, 2.4492935982947064e-16, rr);
            const double r2 = rr * rr;
            double sp = -1.0 / 25852016738884976640000.0;
            sp = sp * r2 + 1.0 / 51090942171709440000.0;
            sp = sp * r2 - 1.0 / 121645100408832000.0;
            sp = sp * r2 + 1.0 / 355687428096000.0;
            sp = sp * r2 - 1.0 / 1307674368000.0;
            sp = sp * r2 + 1.0 / 6227020800.0;
            sp = sp * r2 - 1.0 / 39916800.0;
            sp = sp * r2 + 1.0 / 362880.0;
            sp = sp * r2 - 1.0 / 5040.0;
            sp = sp * r2 + 1.0 / 120.0;
            sp = sp * r2 - 1.0 / 6.0;
            sp = sp * r2 + 1.0;
            double cp = 1.0 / 620448401733239439360000.0;
            cp = cp * r2 - 1.0 / 1124000727777607680000.0;
            cp = cp * r2 + 1.0 / 2432902008176640000.0;
            cp = cp * r2 - 1.0 / 6402373705728000.0;
            cp = cp * r2 + 1.0 / 20922789888000.0;
            cp = cp * r2 - 1.0 / 87178291200.0;
            cp = cp * r2 + 1.0 / 479001600.0;
            cp = cp * r2 - 1.0 / 3628800.0;
            cp = cp * r2 + 1.0 / 40320.0;
            cp = cp * r2 - 1.0 / 720.0;
            cp = cp * r2 + 1.0 / 24.0;
            cp = cp * r2 - 0.5;
            cp = cp * r2 + 1.0;
            RCOS[idx] = (float)cp; RSIN[idx] = (float)(sp * rr);
        }
    }
    SEAM(0);

    if (IN(1)) {
        pg8::Gemm g{XB, BIN, MROWS, NIN, DM}; pg8::StaticOrder S; S.init(MROWS, NIN, G, bx);
        pg8::EpiIn E{H, GLR, RCOS, RSIN, out};
        pg8::gemm_phase<pg8::EpiIn, pg8::StaticOrder, true, true>(lds, g, S, E);
    }
    SEAM(1);

    if (IN(2)) {
        const bool dec_first = (bx & 1) != 0;
        if (dec_first) { for (int u = bx; u < 1664; u += G) attn_dec_unit(lds, u, ck0, ck1, ck2, H, OAT, LSE, lane, wid); __syncthreads(); }
        for (int u = bx; u < 256; u += G) g1_unit(lds, u, H, GLR, w_gk_b, b_gk, LBUF, DC, tid, lane, wid);
        __syncthreads();
        for (int u = bx; u < 512; u += G) gla_sample_unit(lds, u, H, GLR, w_gk_b, b_gk, state_gla, gla_norm, out, OG, tid, lane, wid);
        __syncthreads();
        for (int u = bx; u < 3072; u += G) attn_prompt_unit(lds, u, H, OAT, LSE, tid, lane, wid);
        __syncthreads();
        if (!dec_first) { for (int u = bx; u < 1664; u += G) attn_dec_unit(lds, u, ck0, ck1, ck2, H, OAT, LSE, lane, wid); }
    }
    SEAM(2);

    if (IN(3)) {
        for (int e = gt; e < 8 * 32768; e += NGT) {
            const int bh = e >> 15, idx = e & 32767, v = idx >> 7, k = idx & 127;
            float s = 0.f;
#pragma unroll 1
            for (int c0 = 0; c0 < 32; c0 += 8) {
                float lv[8], dv[8];
#pragma unroll
                for (int c = 0; c < 8; ++c) { const int unit = bh * 32 + c0 + c; lv[c] = LBUF[(size_t)unit * 32768 + idx]; dv[c] = DC[unit * 128 + k]; }
#pragma unroll
                for (int c = 0; c < 8; ++c) { const int unit = bh * 32 + c0 + c; SBUF[(size_t)unit * 32768 + idx] = f2bf(s); s = dv[c] * s + lv[c]; }
            }
            out[OFF_GSP + ((size_t)bh * 128 + k) * 256 + v] = s;
        }
        for (int e = gt; e < MROWS * 64; e += NGT) {
            const int row = e >> 6, pc = e & 63, hh = pc >> 3;
            const float l0 = LSE[((size_t)0 * MROWS + row) * 8 + hh], l1 = LSE[((size_t)1 * MROWS + row) * 8 + hh], l2 = LSE[((size_t)2 * MROWS + row) * 8 + hh];
            const float mx = fmaxf(l0, fmaxf(l1, l2));
            float w0 = __builtin_amdgcn_exp2f(l0 - mx), w1 = __builtin_amdgcn_exp2f(l1 - mx), w2 = __builtin_amdgcn_exp2f(l2 - mx);
            const float inv = 1.0f / (w0 + w1 + w2); w0 *= inv; w1 *= inv; w2 *= inv;
            const u32x4 a = *(const u32x4*)(OAT + ((size_t)0 * MROWS + row) * 512 + pc * 8), bq = *(const u32x4*)(OAT + ((size_t)1 * MROWS + row) * 512 + pc * 8), cq = *(const u32x4*)(OAT + ((size_t)2 * MROWS + row) * 512 + pc * 8);
            u32x4 o;
            o.x = pkbf(w0 * bflo(a.x) + w1 * bflo(bq.x) + w2 * bflo(cq.x), w0 * bfhi(a.x) + w1 * bfhi(bq.x) + w2 * bfhi(cq.x));
            o.y = pkbf(w0 * bflo(a.y) + w1 * bflo(bq.y) + w2 * bflo(cq.y), w0 * bfhi(a.y) + w1 * bfhi(bq.y) + w2 * bfhi(cq.y));
            o.z = pkbf(w0 * bflo(a.z) + w1 * bflo(bq.z) + w2 * bflo(cq.z), w0 * bfhi(a.z) + w1 * bfhi(bq.z) + w2 * bfhi(cq.z));
            o.w = pkbf(w0 * bflo(a.w) + w1 * bflo(bq.w) + w2 * bflo(cq.w), w0 * bfhi(a.w) + w1 * bfhi(bq.w) + w2 * bfhi(cq.w));
            *(u32x4*)(OD + (size_t)row * 512 + pc * 8) = o;
        }
    }
    SEAM(3);

    if (IN(4)) {
        for (int u = bx; u < 256; u += G) { g3_unit(lds, u, H, GLR, w_gk_b, b_gk, SBUF, gla_norm, OG, tid, lane, wid); __syncthreads(); }
    }
    SEAM(4);

    if (IN(5)) {
        { pg8::Gemm g{OG, BBG, MROWS, DM, DM}; pg8::StaticOrder S; S.init(MROWS, DM, G, bx); pg8::EpiGateT E{H + C_GA, HLD, T};
          pg8::gemm_phase<pg8::EpiGateT, pg8::StaticOrder, true, true>(lds, g, S, E); }
        __syncthreads();
        { pg8::Gemm g{OD, BBD, MROWS, DM, 512}; pg8::StaticOrder S; S.init(MROWS, DM, G, bx); pg8::EpiGateM E{H + C_GB, HLD, T, MB};
          pg8::gemm_phase<pg8::EpiGateM, pg8::StaticOrder, true, true>(lds, g, S, E); }
    }
    SEAM(5);

    if (IN(6)) {
        { pg8::Gemm g{MB, BOUT, MROWS, DM, DM}; pg8::StaticOrder S; S.init(MROWS, DM, G, bx); pg8::EpiRes E{x_prompt, x_sample, R};
          pg8::gemm_phase<pg8::EpiRes, pg8::StaticOrder, true, true>(lds, g, S, E); }
        __syncthreads();
        { pg8::Gemm g{PEB, BPP, MROWS, DM, 256}; pg8::StaticOrder S; S.init(MROWS, DM, G, bx); pg8::EpiF32 E{PP};
          pg8::gemm_phase<pg8::EpiF32, pg8::StaticOrder, true, true>(lds, g, S, E); }
    }
    SEAM(6);
    if (IN(7)) ln_pass(R, ln1_g, ln1_b, X1, X1B, gw, NGW, lane);
    SEAM(7);
    if (IN(8)) {
        pg8::Gemm g{X1B, BUP, MROWS, FF, DM}; pg8::StaticOrder S; S.init(MROWS, FF, G, bx); pg8::EpiA E{AB, out};
        pg8::gemm_phase<pg8::EpiA, pg8::StaticOrder, true, true>(lds, g, S, E);
    }
    SEAM(8);
    if (IN(9)) {
        pg8::Gemm g{X1B, BUP + (size_t)FF * DM, MROWS, FF, DM}; pg8::StaticOrder S; S.init(MROWS, FF, G, bx); pg8::EpiU E{AB, cache_conv, conv_w, conv_b, HM};
        pg8::gemm_phase<pg8::EpiU, pg8::StaticOrder, true, true>(lds, g, S, E);
    }
    SEAM(9);
    if (IN(10)) {
        pg8::Gemm g{HM, BDN, MROWS, DM, FF}; pg8::StaticOrder S; S.init(MROWS, DM, G, bx); pg8::EpiRes E{X1, X1 + (size_t)MP * DM, R};
        pg8::gemm_phase<pg8::EpiRes, pg8::StaticOrder, true, true>(lds, g, S, E);
    }
    SEAM(10);
    if (IN(11)) ln_pass(R, ln2_g, ln2_b, X2, X2B, gw, NGW, lane);
    SEAM(11);
    if (IN(12)) {
        pg8::Gemm g{X2B, BPG, MROWS, DM, DM}; pg8::StaticOrder S; S.init(MROWS, DM, G, bx); pg8::EpiPle E{X2, PP, R};
        pg8::gemm_phase<pg8::EpiPle, pg8::StaticOrder, true, true>(lds, g, S, E);
    }
    SEAM(12);
    if (IN(13)) ln_pass(R, ln3_g, ln3_b, out + OFF_Y, nullptr, gw, NGW, lane);
#undef IN
#undef SEAM
}

#undef x_prompt
#undef x_sample
#undef p_prompt
#undef p_sample
#undef state_gla
#undef cache_conv
#undef ck0
#undef ck1
#undef ck2
#undef w_in
#undef w_gk_b
#undef b_gk
#undef gla_norm
#undef w_br_gla
#undef w_br_dil
#undef w_out
#undef ln1_g
#undef ln1_b
#undef w_up
#undef conv_w
#undef conv_b
#undef w_down
#undef ln2_g
#undef ln2_b
#undef w_ple_gate
#undef w_ple_proj
#undef ln3_g
#undef ln3_b
#undef RCOS
#undef RSIN
#undef BIN
#undef BBG
#undef BBD
#undef BOUT
#undef BUP
#undef BDN
#undef BPG
#undef BPP
#undef XB
#undef PEB
#undef GLR
#undef DC
#undef LSE
#undef H
#undef LBUF
#undef SBUF
#undef OAT
#undef OD
#undef OG
#undef T
#undef MB
#undef R
#undef X1
#undef X1B
#undef AB
#undef HM
#undef X2
#undef X2B
#undef PP
#undef out
#ifndef MK_N_LAUNCHES
#define MK_N_LAUNCHES 1
#endif
extern "C" void kernel_launch(void* const* d_in, const int* in_sizes, int n_in, void* d_out, int out_size, void* d_ws, size_t ws_size, hipStream_t stream) {
    static int grid = 0;
    if (grid == 0) {
        if (n_in != 28 || out_size != (int)OUT_TOTAL || ws_size < WS_END) { fprintf(stderr, "kernel_launch: unexpected sizes (n_in %d, out %d, ws %zu)\n", n_in, out_size, ws_size); grid = -1; return; }
        int dev = 0, cus = 0, per_cu = 0;
        if (hipGetDevice(&dev) != hipSuccess || hipDeviceGetAttribute(&cus, hipDeviceAttributeMultiprocessorCount, dev) != hipSuccess) { grid = -1; return; }
        if (hipFuncSetAttribute((const void*)mk_fwd, hipFuncAttributeMaxDynamicSharedMemorySize, LDS_BYTES) != hipSuccess) { fprintf(stderr, "kernel_launch: hipFuncSetAttribute failed\n"); grid = -1; return; }
        if (hipOccupancyMaxActiveBlocksPerMultiprocessor(&per_cu, (const void*)mk_fwd, NTHREADS, LDS_BYTES) != hipSuccess || per_cu < 1) { fprintf(stderr, "kernel_launch: occupancy query says %d\n", per_cu); }
        (void)hipGetLastError();
        grid = cus;
    }
    if (grid < 0) return;
    (void)hipMemsetAsync((char*)d_ws + WS_CTL, 0, CTL_ZERO_BYTES, stream);
    Args a{};
    for (int i = 0; i < 28; ++i) a.in[i] = (const float*)d_in[i];
    a.outp = (float*)d_out; a.wsp = (unsigned char*)d_ws;
    if (MK_N_LAUNCHES == 1) { a.ph_lo = 0; a.ph_hi = N_PHASES; hipLaunchKernelGGL(mk_fwd, dim3(grid), dim3(NTHREADS), LDS_BYTES, stream, a); }
    else { for (int p = 0; p < N_PHASES; ++p) { a.ph_lo = p; a.ph_hi = p + 1; hipLaunchKernelGGL(mk_fwd, dim3(grid), dim3(NTHREADS), LDS_BYTES, stream, a); } }
}
```

```cpp
#include <hip/hip_runtime.h>
#include <cstdio>
#include <cstdint>
#define GAS __attribute__((address_space(1)))
#define LAS __attribute__((address_space(3)))
namespace pg8 {
#define PG8_LAS __attribute__((address_space(3)))
typedef unsigned short bf16_t;
typedef short bf16x8 __attribute__((ext_vector_type(8)));
typedef float f32x4 __attribute__((ext_vector_type(4)));
typedef unsigned u32x4 __attribute__((ext_vector_type(4)));
constexpr int BM = 256, BK = 64, HALF = 128, HTB = HALF * BK * 2  , STAGE_BYTES = 8 * HTB, NXCD = 8, WGM = 8;

__host__ __device__ __forceinline__ int lds_byte(int r, int c) { const int st = (r >> 4) * 2 + (c >> 5), rr = r & 15, cc = c & 31, ob = rr * 64 + cc * 2; return st * 1024 + (ob ^ (((ob >> 9) & 1) << 5)); }
__host__ __device__ __forceinline__ void stage_rc(int b, int& R, int& C) { const int st = b / 1024, sb = b % 1024, swz = sb ^ (((sb >> 9) & 1) << 5); R = (st >> 1) * 16 + swz / 64; C = (st & 1) * 32 + (swz % 64) / 2; }
__host__ __device__ __forceinline__ int perm32(int rho) { const int n = rho >> 4, i = rho & 15; return 8 * (i >> 2) + 4 * n + (i & 3); }

struct Unit { int pm, pn; };
struct Gemm { const bf16_t* A; const bf16_t* Bt; int M, N, K; };

struct StaticOrder {
    int nM, nN, nwg, G, c;
    __host__ __device__ void init(int M, int N, int G_, int c_) { nM = M / BM; nN = N / BM; nwg = nM * nN; G = G_; c = c_; }
    __host__ __device__ bool next(int i, Unit& u) const {
        const long L = (long)i * G + c; if (L >= nwg) return false;
        int wgid = (int)L; { const int q = nwg / NXCD, r = nwg % NXCD, xcd = wgid % NXCD, off = wgid / NXCD; wgid = (xcd < r ? xcd * (q + 1) : r * (q + 1) + (xcd - r) * q) + off; }
        const int nig = WGM * nN, gid = wgid / nig, fm = gid * WGM, gsz = (nM - fm) < WGM ? (nM - fm) : WGM;
        u.pm = fm + ((wgid % nig) % gsz); u.pn = (wgid % nig) / gsz; return true;
    }
    __device__ __forceinline__ void a_ready(const Unit&) const {}
    __device__ __forceinline__ void done(const Unit&) const {}
};

__device__ __forceinline__ unsigned cvt_pk_bf16(float lo, float hi) { unsigned r; asm volatile("v_cvt_pk_bf16_f32 %0, %1, %2" : "=v"(r) : "v"(lo), "v"(hi)); return r; }
typedef float f32x2 __attribute__((ext_vector_type(2)));
__device__ __forceinline__ f32x2 gelu_pk(f32x2 v) {
    const f32x2 av = __builtin_elementwise_abs(v), d = av * 0.2316418882f + 1.0f;
    f32x2 t; t.x = __builtin_amdgcn_rcpf(d.x); t.y = __builtin_amdgcn_rcpf(d.y);
    f32x2 q = t * 0.5307027145f + (-0.7265760135f); q = q * t + 0.7107068705f; q = q * t + (-0.142248368f); q = q * t + 0.127414796f; q = q * t;
    const f32x2 s = (v * v) * (-0.72134752044f);
    f32x2 e; e.x = __builtin_amdgcn_exp2f(s.x); e.y = __builtin_amdgcn_exp2f(s.y);
    const f32x2 m = v * (q * e), r = v - m;
    f32x2 o; o.x = v.x < 0.f ? m.x : r.x; o.y = v.y < 0.f ? m.y : r.y; return o;
}
template <class Epi, class Sched, bool ALIGN_EPI = false, bool SP2 = false>
__device__ __forceinline__ void gemm_phase(PG8_LAS unsigned char* lds, const Gemm g, const Sched& S, const Epi& E) {
    const int tid = threadIdx.x, wid = __builtin_amdgcn_readfirstlane(tid >> 6), lane = tid & 63, wr = wid >> 2, wc = wid & 3, fr = lane & 15, fq = lane >> 4;
    const int K = g.K, nt = K / BK;
    unsigned voffA[2], voffB[2];
#pragma unroll
    for (int i = 0; i < 2; ++i) { int R, C; stage_rc(tid * 16 + i * 8192, R, C); const int Rb = Epi::PERM ? ((R & ~31) + perm32(R & 31)) : R;
        voffA[i] = (unsigned)(R * K + C) * 2u; voffB[i] = (unsigned)(Rb * K + C) * 2u; }
    const size_t kstep = (size_t)(BK * 2);
    const size_t hstep = (size_t)HALF * K * 2;
    const size_t tstep = 2 * hstep;
    const unsigned ldsw = (unsigned)wid * 1024u;
    const int aoff = lds_byte(wr * 64 + fr, fq * 8), boff = lds_byte(wc * 32 + fr, fq * 8);
#define PG8_SA(b, h) (((b) * 2 + (h)) * HTB)
#define PG8_SB(b, h) ((4 + (b) * 2 + (h)) * HTB)
#define PG8_STAGE(bufoff, gbase, voff) do { _Pragma("unroll") for (int _i = 0; _i < 2; ++_i) \
        __builtin_amdgcn_global_load_lds((const unsigned*)((const char*)(gbase) + (voff)[_i]), (PG8_LAS unsigned*)(lds + (bufoff) + ldsw + _i * 8192), 16, 0, 0); } while (0)
#define PG8_LDA(dst, b, h) do { _Pragma("unroll") for (int m = 0; m < 4; ++m) _Pragma("unroll") for (int k = 0; k < 2; ++k) dst[m][k] = *(const PG8_LAS bf16x8*)(lds + PG8_SA(b, h) + aoff + m * 2048 + k * 1024); } while (0)
#define PG8_LDB(dst, b, h) do { _Pragma("unroll") for (int n = 0; n < 2; ++n) _Pragma("unroll") for (int k = 0; k < 2; ++k) dst[n][k] = *(const PG8_LAS bf16x8*)(lds + PG8_SB(b, h) + boff + n * 2048 + k * 1024); } while (0)
#define PG8_MMA(ai, bj, At, Bt) do { __builtin_amdgcn_s_setprio(1); _Pragma("unroll") for (int m = 0; m < 4; ++m) _Pragma("unroll") for (int n = 0; n < 2; ++n) _Pragma("unroll") for (int k = 0; k < 2; ++k) \
        acc[ai][bj][m][n] = __builtin_amdgcn_mfma_f32_16x16x32_bf16(Bt[n][k], At[m][k], acc[ai][bj][m][n], 0, 0, 0); __builtin_amdgcn_s_setprio(0); } while (0)
#define PG8_WAIT_V(n) asm volatile("s_waitcnt vmcnt(" #n ")" ::: "memory")
#define PG8_WAIT_L(n) asm volatile("s_waitcnt lgkmcnt(" #n ")" ::: "memory")
#define PG8_BAR __builtin_amdgcn_s_barrier()
#define PG8_SCHED __builtin_amdgcn_sched_barrier(0)
    Unit cur, nxt; int ui = 0;
    if (!S.next(0, cur)) return;
    f32x4 acc[2][2][4][2];
#pragma unroll
    for (int a = 0; a < 2; ++a)
#pragma unroll
        for (int b = 0; b < 2; ++b)
#pragma unroll
            for (int m = 0; m < 4; ++m)
#pragma unroll
                for (int n = 0; n < 2; ++n) acc[a][b][m][n] = (f32x4){0.f, 0.f, 0.f, 0.f};
    bf16x8 At[4][2], B0[2][2], B1[2][2];
    const char* cA = (const char*)g.A + (size_t)cur.pm * tstep; const char* cB = (const char*)g.Bt + (size_t)cur.pn * tstep;
    S.a_ready(cur);
    if constexpr (SP2) {
        PG8_STAGE(PG8_SB(0, 0), cB, voffB); PG8_STAGE(PG8_SB(0, 1), cB + hstep, voffB); PG8_STAGE(PG8_SA(0, 0), cA, voffA); PG8_STAGE(PG8_SA(0, 1), cA + hstep, voffA);
        if (wr == 1) PG8_BAR;
        PG8_WAIT_V(2); PG8_BAR;
        PG8_STAGE(PG8_SB(1, 0), cB + kstep, voffB); PG8_STAGE(PG8_SA(1, 0), cA + kstep, voffA); PG8_STAGE(PG8_SB(1, 1), cB + hstep + kstep, voffB);
        PG8_WAIT_V(6); PG8_BAR;
    } else {
        PG8_STAGE(PG8_SB(0, 0), cB, voffB); PG8_STAGE(PG8_SA(0, 0), cA, voffA); PG8_STAGE(PG8_SB(0, 1), cB + hstep, voffB); PG8_STAGE(PG8_SA(0, 1), cA + hstep, voffA);
        if (wr == 1) PG8_BAR;
        PG8_WAIT_V(4); PG8_BAR;
        PG8_STAGE(PG8_SB(1, 0), cB + kstep, voffB); PG8_STAGE(PG8_SA(1, 0), cA + kstep, voffA); PG8_STAGE(PG8_SB(1, 1), cB + hstep + kstep, voffB);
        PG8_WAIT_V(6); PG8_BAR;
    }
    for (;;) {
        const bool has_next = S.next(ui + 1, nxt);
        const char* nA = has_next ? (const char*)g.A + (size_t)nxt.pm * tstep : cA; const char* nB = has_next ? (const char*)g.Bt + (size_t)nxt.pn * tstep : cB;
        for (int t = 0; t < nt; t += 2) {
            const bool last = (t == nt - 2);
            const char* a1 = cA + (size_t)(t + 1) * kstep;
            const char* a2 = last ? nA : cA + (size_t)(t + 2) * kstep; const char* b2 = last ? nB : cB + (size_t)(t + 2) * kstep;
            const char* a3 = a2 + kstep; const char* b3 = b2 + kstep;
            if (last && has_next) S.a_ready(nxt);
            if constexpr (SP2) {
            PG8_LDB(B0, 0, 0); PG8_LDB(B1, 0, 1); PG8_SCHED; PG8_LDA(At, 0, 0); PG8_STAGE(PG8_SA(1, 1), a1 + hstep, voffA);
            PG8_WAIT_V(8); PG8_WAIT_L(0); PG8_BAR; PG8_MMA(0, 0, At, B0); PG8_MMA(0, 1, At, B1); PG8_BAR; PG8_SCHED;
            PG8_LDA(At, 0, 1); PG8_STAGE(PG8_SB(0, 0), b2, voffB); PG8_STAGE(PG8_SB(0, 1), b2 + hstep, voffB); PG8_STAGE(PG8_SA(0, 0), a2, voffA);
            PG8_WAIT_V(8); PG8_WAIT_L(0); PG8_BAR; PG8_MMA(1, 0, At, B0); PG8_MMA(1, 1, At, B1); PG8_BAR; PG8_SCHED;
            PG8_LDB(B0, 1, 0); PG8_LDB(B1, 1, 1); PG8_SCHED; PG8_LDA(At, 1, 0); PG8_STAGE(PG8_SA(0, 1), a2 + hstep, voffA);
            PG8_WAIT_V(8); PG8_WAIT_L(0); PG8_BAR; PG8_MMA(0, 0, At, B0); PG8_MMA(0, 1, At, B1); PG8_BAR; PG8_SCHED;
            PG8_LDA(At, 1, 1); PG8_STAGE(PG8_SB(1, 0), b3, voffB); PG8_STAGE(PG8_SB(1, 1), b3 + hstep, voffB); PG8_STAGE(PG8_SA(1, 0), a3, voffA);
            PG8_WAIT_V(8); PG8_WAIT_L(0); PG8_BAR; PG8_MMA(1, 0, At, B0); PG8_MMA(1, 1, At, B1); PG8_BAR; PG8_SCHED;
            } else {
            PG8_LDB(B0, 0, 0); PG8_SCHED; PG8_LDA(At, 0, 0); PG8_STAGE(PG8_SA(1, 1), a1 + hstep, voffA);
            PG8_WAIT_L(8); PG8_BAR; PG8_WAIT_L(0); PG8_MMA(0, 0, At, B0); PG8_BAR; PG8_SCHED;
            PG8_LDB(B1, 0, 1); PG8_STAGE(PG8_SB(0, 0), b2, voffB);
            PG8_BAR; PG8_WAIT_L(0); PG8_MMA(0, 1, At, B1); PG8_BAR;
            PG8_LDA(At, 0, 1); PG8_STAGE(PG8_SA(0, 0), a2, voffA);
            PG8_BAR; PG8_WAIT_L(0); PG8_MMA(1, 0, At, B0); PG8_BAR; PG8_SCHED;
            PG8_STAGE(PG8_SB(0, 1), b2 + hstep, voffB);
            PG8_WAIT_V(6); PG8_BAR; PG8_MMA(1, 1, At, B1); PG8_BAR;
            PG8_LDB(B0, 1, 0); PG8_SCHED; PG8_LDA(At, 1, 0); PG8_STAGE(PG8_SA(0, 1), a2 + hstep, voffA);
            PG8_WAIT_L(8); PG8_BAR; PG8_WAIT_L(0); PG8_MMA(0, 0, At, B0); PG8_BAR; PG8_SCHED;
            PG8_LDB(B1, 1, 1); PG8_STAGE(PG8_SB(1, 0), b3, voffB);
            PG8_BAR; PG8_WAIT_L(0); PG8_MMA(0, 1, At, B1); PG8_BAR;
            PG8_LDA(At, 1, 1); PG8_STAGE(PG8_SA(1, 0), a3, voffA);
            PG8_BAR; PG8_WAIT_L(0); PG8_MMA(1, 0, At, B0); PG8_BAR; PG8_SCHED;
            PG8_STAGE(PG8_SB(1, 1), b3 + hstep, voffB);
            PG8_WAIT_V(6); PG8_BAR; PG8_MMA(1, 1, At, B1); PG8_BAR;
            }
        }
        if constexpr (ALIGN_EPI) { if (wr == 0) PG8_BAR; }
        if constexpr (!Epi::AFTER_DRAIN) { E(acc, cur, wr, wc, fr, fq); S.done(cur); }
        if (!has_next) break;
#pragma unroll
        for (int a = 0; a < 2; ++a)
#pragma unroll
            for (int b = 0; b < 2; ++b)
#pragma unroll
                for (int m = 0; m < 4; ++m)
#pragma unroll
                    for (int n = 0; n < 2; ++n) acc[a][b][m][n] = (f32x4){0.f, 0.f, 0.f, 0.f};
        cur = nxt; cA = nA; cB = nB; ++ui;
        if constexpr (ALIGN_EPI) { if (wr == 1) PG8_BAR; }
    }
    PG8_WAIT_V(0);
    if constexpr (!ALIGN_EPI) { if (wr == 0) PG8_BAR; }
    PG8_BAR;
    if constexpr (Epi::AFTER_DRAIN) { E.fused(acc, cur, wr, wc, fr, fq, lds, wid, lane); S.done(cur); }
#undef PG8_SA
#undef PG8_SB
#undef PG8_STAGE
#undef PG8_LDA
#undef PG8_LDB
#undef PG8_MMA
#undef PG8_WAIT_V
#undef PG8_WAIT_L
#undef PG8_BAR
#undef PG8_SCHED
}
}

namespace pg8 {
constexpr int XS_OFF = STAGE_BYTES, STAGE_BYTES_X = STAGE_BYTES + 4096;
struct GemmX { const bf16_t* A; const bf16_t* AX; const bf16_t* Bt; int N, K; };
struct OrderX {
    int nN, nwg, G, c;
    __host__ __device__ void init(int N, int G_, int c_) { nN = N / BM; nwg = 64 * nN; G = G_; c = c_; }
    __host__ __device__ bool next(int i, Unit& u) const {
        const long L = (long)i * G + c; if (L >= nwg) return false;
        int wgid = (int)L; { const int q = nwg / NXCD, r = nwg % NXCD, xcd = wgid % NXCD, off = wgid / NXCD; wgid = (xcd < r ? xcd * (q + 1) : r * (q + 1) + (xcd - r) * q) + off; }
        const int nig = WGM * nN, gid = wgid / nig, fm = gid * WGM;
        u.pm = fm + ((wgid % nig) % WGM); u.pn = (wgid % nig) / WGM; return true;
    }
};
template <class Epi>
__device__ __forceinline__ void gemm_phase_x(PG8_LAS unsigned char* lds, const GemmX g, const OrderX& S, const Epi& E) {
    static_assert(Epi::PERM, "gemm_phase_x epilogues use the PERM layout");
    int lane; asm volatile("v_mbcnt_lo_u32_b32 %0, -1, 0\n\tv_mbcnt_hi_u32_b32 %0, -1, %0" : "=v"(lane));
    const int wid = __builtin_amdgcn_readfirstlane((int)threadIdx.x >> 6), tid = wid * 64 + lane, wr = wid >> 2, wc = wid & 3, fr = lane & 15, fq = lane >> 4;
    const int K = g.K, nt = K / BK;
    unsigned voffA[2], voffB[2], voffX;
#pragma unroll
    for (int i = 0; i < 2; ++i) { int R, C; stage_rc(tid * 16 + i * 8192, R, C); const int Rb = (R & ~31) + perm32(R & 31);
        voffA[i] = (unsigned)(R * K + C) * 2u; voffB[i] = (unsigned)(Rb * K + C) * 2u; }
    { int R, C; stage_rc(wid * 256 + (lane & 15) * 16, R, C); voffX = (unsigned)(R * K + C) * 2u; }
    const unsigned kstep = (unsigned)(BK * 2);
    const unsigned hstep = (unsigned)HALF * (unsigned)K * 2u;
    const unsigned tstep = 2u * hstep;
    const unsigned xstep = 16u * (unsigned)K * 2u;
    const unsigned ldsw = (unsigned)wid * 1024u;
    const unsigned ldsx = (unsigned)wid * 256u;
    const int aoff = lds_byte(wr * 64 + fr, fq * 8), boff = lds_byte(wc * 32 + fr, fq * 8), xoff = lds_byte(fr, fq * 8);
    const bool xl = lane < 16;
#define PG8_SA(b, h) (((b) * 2 + (h)) * HTB)
#define PG8_SB(b, h) ((4 + (b) * 2 + (h)) * HTB)
#define PG8_SX(b) (XS_OFF + (b) * 2048)
#define PG8_STAGE(bufoff, gbase, uoff, voff) do { _Pragma("unroll") for (int _i = 0; _i < 2; ++_i) \
        __builtin_amdgcn_global_load_lds((const unsigned*)((const char*)(gbase) + (size_t)(unsigned)((uoff) + (voff)[_i])), (PG8_LAS unsigned*)(lds + (bufoff) + ldsw + _i * 8192), 16, 0, 0); } while (0)
#define PG8_STAGEX(bufoff, uoff) do { if (xl) __builtin_amdgcn_global_load_lds((const unsigned*)((const char*)(g.AX) + (size_t)(unsigned)((uoff) + voffX)), (PG8_LAS unsigned*)(lds + (bufoff) + ldsx), 16, 0, 0); } while (0)
#define PG8_LDA(dst, b, h) do { _Pragma("unroll") for (int m = 0; m < 4; ++m) _Pragma("unroll") for (int k = 0; k < 2; ++k) dst[m][k] = *(const PG8_LAS bf16x8*)(lds + PG8_SA(b, h) + aoff + m * 2048 + k * 1024); } while (0)
#define PG8_LDB(dst, b, h) do { _Pragma("unroll") for (int n = 0; n < 2; ++n) _Pragma("unroll") for (int k = 0; k < 2; ++k) dst[n][k] = *(const PG8_LAS bf16x8*)(lds + PG8_SB(b, h) + boff + n * 2048 + k * 1024); } while (0)
#define PG8_LDX(dst, b) do { _Pragma("unroll") for (int k = 0; k < 2; ++k) dst[k] = *(const PG8_LAS bf16x8*)(lds + PG8_SX(b) + xoff + k * 1024); } while (0)
#define PG8_MMA(ai, bj, At, Bt) do { __builtin_amdgcn_s_setprio(1); _Pragma("unroll") for (int m = 0; m < 4; ++m) _Pragma("unroll") for (int n = 0; n < 2; ++n) _Pragma("unroll") for (int k = 0; k < 2; ++k) \
        acc[ai][bj][m][n] = __builtin_amdgcn_mfma_f32_16x16x32_bf16(Bt[n][k], At[m][k], acc[ai][bj][m][n], 0, 0, 0); __builtin_amdgcn_s_setprio(0); } while (0)
#define PG8_MMAX() do { if (wr == 0) { _Pragma("unroll") for (int n = 0; n < 2; ++n) _Pragma("unroll") for (int k = 0; k < 2; ++k) accx[n] = __builtin_amdgcn_mfma_f32_16x16x32_bf16(B0[n][k], Ax[k], accx[n], 0, 0, 0); } \
        else { _Pragma("unroll") for (int n = 0; n < 2; ++n) _Pragma("unroll") for (int k = 0; k < 2; ++k) accx[n] = __builtin_amdgcn_mfma_f32_16x16x32_bf16(B1[n][k], Ax[k], accx[n], 0, 0, 0); } } while (0)
#define PG8_WAIT_V(n) asm volatile("s_waitcnt vmcnt(" #n ")" ::: "memory")
#define PG8_WAIT_L(n) asm volatile("s_waitcnt lgkmcnt(" #n ")" ::: "memory")
#define PG8_BAR __builtin_amdgcn_s_barrier()
#define PG8_SCHED __builtin_amdgcn_sched_barrier(0)
    Unit cur, nxt; int ui = 0;
    if (!S.next(0, cur)) return;
    f32x4 acc[2][2][4][2]; f32x4 accx[2];
#pragma unroll
    for (int a = 0; a < 2; ++a)
#pragma unroll
        for (int b = 0; b < 2; ++b)
#pragma unroll
            for (int m = 0; m < 4; ++m)
#pragma unroll
                for (int n = 0; n < 2; ++n) acc[a][b][m][n] = (f32x4){0.f, 0.f, 0.f, 0.f};
    accx[0] = (f32x4){0.f, 0.f, 0.f, 0.f}; accx[1] = (f32x4){0.f, 0.f, 0.f, 0.f};
    bf16x8 At[4][2], B0[2][2], B1[2][2], Ax[2];
    unsigned cA = (unsigned)cur.pm * tstep, cB = (unsigned)cur.pn * tstep, cX = (unsigned)cur.pm * xstep;
    PG8_STAGE(PG8_SB(0, 0), g.Bt, cB, voffB); PG8_STAGE(PG8_SB(0, 1), g.Bt, cB + hstep, voffB); PG8_STAGE(PG8_SA(0, 0), g.A, cA, voffA); PG8_STAGE(PG8_SA(0, 1), g.A, cA + hstep, voffA); PG8_STAGEX(PG8_SX(0), cX);
    if (wr == 1) PG8_BAR;
    PG8_WAIT_V(3); PG8_BAR;
    PG8_STAGE(PG8_SB(1, 0), g.Bt, cB + kstep, voffB); PG8_STAGE(PG8_SA(1, 0), g.A, cA + kstep, voffA); PG8_STAGE(PG8_SB(1, 1), g.Bt, cB + hstep + kstep, voffB);
    PG8_WAIT_V(6); PG8_BAR;
    for (;;) {
        const bool has_next = S.next(ui + 1, nxt);
        const unsigned nA = has_next ? (unsigned)nxt.pm * tstep : cA, nB = has_next ? (unsigned)nxt.pn * tstep : cB, nX = has_next ? (unsigned)nxt.pm * xstep : cX;
        for (int t = 0; t < nt; t += 2) {
            const bool last = (t == nt - 2);
            const unsigned a1 = cA + (unsigned)(t + 1) * kstep, x1 = cX + (unsigned)(t + 1) * kstep;
            const unsigned a2 = last ? nA : cA + (unsigned)(t + 2) * kstep, b2 = last ? nB : cB + (unsigned)(t + 2) * kstep, x2 = last ? nX : cX + (unsigned)(t + 2) * kstep;
            const unsigned a3 = a2 + kstep, b3 = b2 + kstep;
            PG8_LDB(B0, 0, 0); PG8_LDB(B1, 0, 1); PG8_SCHED; PG8_LDA(At, 0, 0); PG8_STAGE(PG8_SA(1, 1), g.A, a1 + hstep, voffA); PG8_STAGEX(PG8_SX(1), x1);
            PG8_WAIT_V(9); PG8_WAIT_L(0); PG8_BAR; PG8_MMA(0, 0, At, B0); PG8_MMA(0, 1, At, B1); PG8_BAR; PG8_SCHED;
            PG8_LDA(At, 0, 1); PG8_LDX(Ax, 0); PG8_STAGE(PG8_SB(0, 0), g.Bt, b2, voffB); PG8_STAGE(PG8_SB(0, 1), g.Bt, b2 + hstep, voffB); PG8_STAGE(PG8_SA(0, 0), g.A, a2, voffA);
            PG8_WAIT_V(9); PG8_WAIT_L(0); PG8_BAR; PG8_MMA(1, 0, At, B0); PG8_MMA(1, 1, At, B1); PG8_MMAX(); PG8_BAR; PG8_SCHED;
            PG8_LDB(B0, 1, 0); PG8_LDB(B1, 1, 1); PG8_SCHED; PG8_LDA(At, 1, 0); PG8_STAGE(PG8_SA(0, 1), g.A, a2 + hstep, voffA); PG8_STAGEX(PG8_SX(0), x2);
            PG8_WAIT_V(9); PG8_WAIT_L(0); PG8_BAR; PG8_MMA(0, 0, At, B0); PG8_MMA(0, 1, At, B1); PG8_BAR; PG8_SCHED;
            PG8_LDA(At, 1, 1); PG8_LDX(Ax, 1); PG8_STAGE(PG8_SB(1, 0), g.Bt, b3, voffB); PG8_STAGE(PG8_SB(1, 1), g.Bt, b3 + hstep, voffB); PG8_STAGE(PG8_SA(1, 0), g.A, a3, voffA);
            PG8_WAIT_V(9); PG8_WAIT_L(0); PG8_BAR; PG8_MMA(1, 0, At, B0); PG8_MMA(1, 1, At, B1); PG8_MMAX(); PG8_BAR; PG8_SCHED;
        }
        if (wr == 0) PG8_BAR;
        E(acc, accx, cur, wr, wc, fr, fq);
        if (!has_next) break;
#pragma unroll
        for (int a = 0; a < 2; ++a)
#pragma unroll
            for (int b = 0; b < 2; ++b)
#pragma unroll
                for (int m = 0; m < 4; ++m)
#pragma unroll
                    for (int n = 0; n < 2; ++n) acc[a][b][m][n] = (f32x4){0.f, 0.f, 0.f, 0.f};
        accx[0] = (f32x4){0.f, 0.f, 0.f, 0.f}; accx[1] = (f32x4){0.f, 0.f, 0.f, 0.f};
        cur = nxt; cA = nA; cB = nB; cX = nX; ++ui;
        if (wr == 1) PG8_BAR;
    }
    PG8_WAIT_V(0);
    PG8_BAR;
#undef PG8_SA
#undef PG8_SB
#undef PG8_SX
#undef PG8_STAGE
#undef PG8_STAGEX
#undef PG8_LDA
#undef PG8_LDB
#undef PG8_LDX
#undef PG8_MMA
#undef PG8_MMAX
#undef PG8_WAIT_V
#undef PG8_WAIT_L
#undef PG8_BAR
#undef PG8_SCHED
}
}
#define RLX_AGENT __ATOMIC_RELAXED, __HIP_MEMORY_SCOPE_AGENT
#define XB_TMO      128
#define XB_XCNT(j)  (256  + 64 * (j))
#define XB_XSUB(j)  (1280 + 64 * (j))
#define XB_XGEN(j)  (2304 + 64 * (j))
#define XB_TOP      3328
#define XB_TOPGEN   3392
#define XCD_BAR_WORDS 3456
#define XB_SPIN_CAP (1u << 18)

__device__ __forceinline__ unsigned xb_ld(unsigned* p)              { return __hip_atomic_load(p, __ATOMIC_RELAXED, __HIP_MEMORY_SCOPE_AGENT); }
__device__ __forceinline__ unsigned xb_add(unsigned* p, unsigned v) { return __hip_atomic_fetch_add(p, v, __ATOMIC_RELAXED, __HIP_MEMORY_SCOPE_AGENT); }
__device__ __forceinline__ unsigned xb_xcc_id() { return (unsigned)__builtin_amdgcn_s_getreg((3 << 11) | 20) & 0xFu; }
#define XB_SPIN(cond, bar) do { unsigned _sp = 0; while (cond) { __builtin_amdgcn_s_sleep(1); \
    if ((++_sp & 255u) == 0u) { if (xb_ld(&(bar)[XB_TMO])) break; if (_sp > XB_SPIN_CAP) { atomicAdd(&(bar)[XB_TMO], 1u); break; } } } } while (0)

struct XcdBarrier {
    unsigned* bar; unsigned x;
    volatile LAS unsigned* st;
};

__device__ __forceinline__ XcdBarrier xcd_barrier_post(unsigned* bar, volatile LAS unsigned* st) {
    XcdBarrier b; b.bar = bar; b.x = xb_xcc_id(); b.st = st;
    if (threadIdx.x == 0) (void)xb_add(&bar[XB_XCNT(b.x)], 1u);
    return b;
}
__device__ __forceinline__ void xcd_barrier_complete(unsigned* bar, unsigned x, unsigned& nloc, unsigned& nx) {
    const unsigned G = gridDim.x * gridDim.y * gridDim.z;
    unsigned sum, cnt, mine, sp = 0u;
    for (;;) {
        sum = 0u; cnt = 0u; mine = 0u;
#pragma unroll
        for (unsigned j = 0; j < 16; ++j) { const unsigned c = xb_ld(&bar[XB_XCNT(j)]); sum += c; cnt += (c > 0u) ? 1u : 0u; mine = (j == x) ? c : mine; }
        if (sum == G) break;
        __builtin_amdgcn_s_sleep(1);
        if ((++sp & 255u) == 0u) { if (xb_ld(&bar[XB_TMO])) break; if (sp > XB_SPIN_CAP) { atomicAdd(&bar[XB_TMO], 1u); break; } }
    }
    nloc = mine > 0u ? mine : 1u; nx = cnt > 0u ? cnt : 1u;
}

__device__ __forceinline__ void xcd_barrier(const XcdBarrier& b) {
    asm volatile("s_waitcnt vmcnt(0)" ::: "memory");
    __syncthreads();
    if (threadIdx.x == 0) {
        unsigned* bar = b.bar;
        __builtin_amdgcn_s_waitcnt(0);
        unsigned nloc = b.st[0], nx = b.st[1];
        if (nloc == 0u) { xcd_barrier_complete(bar, b.x, nloc, nx); b.st[0] = nloc; b.st[1] = nx; }
        const unsigned old = xb_add(&bar[XB_XSUB(b.x)], 1u);
        const unsigned gen = old / nloc;
        if (old + 1u == (gen + 1u) * nloc) {
            __builtin_amdgcn_fence(__ATOMIC_RELEASE, "agent");
            asm volatile("s_waitcnt vmcnt(0)" ::: "memory");
            const unsigned og = xb_add(&bar[XB_TOP], 1u);
            const unsigned tg = og / nx;
            if (og + 1u == (tg + 1u) * nx) xb_add(&bar[XB_TOPGEN], 1u);
            else XB_SPIN(xb_ld(&bar[XB_TOPGEN]) == tg, bar);
            __builtin_amdgcn_fence(__ATOMIC_ACQUIRE, "agent");
            xb_add(&bar[XB_XGEN(b.x)], 1u);
            asm volatile("s_waitcnt vmcnt(0)" ::: "memory");
        } else {
            XB_SPIN(xb_ld(&bar[XB_XGEN(b.x)]) == gen, bar);
            __builtin_amdgcn_fence(__ATOMIC_ACQUIRE, "agent");
            asm volatile("s_waitcnt vmcnt(0)" ::: "memory");
        }
    }
    __syncthreads();
}

typedef unsigned short bf16;
typedef unsigned u32x4 __attribute__((ext_vector_type(4)));
typedef unsigned u32x2 __attribute__((ext_vector_type(2)));
typedef float f32x4 __attribute__((ext_vector_type(4)));
typedef float f32x2 __attribute__((ext_vector_type(2)));
typedef short bf16x8 __attribute__((ext_vector_type(8)));
typedef short v4s __attribute__((ext_vector_type(4)));
typedef __bf16 bf16x2v __attribute__((ext_vector_type(2)));

constexpr int NWAVES = 8, NTHREADS = 512;
constexpr int DM = 1024, MP = 16384, MSMP = 1024, MROWS = 17408, TP = 8192;
constexpr int HLD = 9728;
constexpr int NIN = 9984;
constexpr int C_GQ = 0, C_GK = 512, C_GV = 1024, C_GG = 2048, C_DQ = 3072, C_DK = 4608, C_DV = 6144, C_GA = 7680, C_GB = 8704;
constexpr int FF = 2816;
constexpr float ALPHA = 1.189207115002721f;
constexpr float LN_EPS = 1e-5f;
constexpr float QSCALE_GLA = 0.08838834764831845f;
constexpr float QSCALE_DIL = 0.125f * 1.4426950408889634f;

constexpr size_t MiB = 1u << 20;
constexpr size_t WS_CTL = 0, CTL_ZERO_BYTES = 1 * MiB;
constexpr size_t WS_RCOS = 2 * MiB, WS_RSIN = 4 * MiB;
constexpr size_t WS_BIN = 8 * MiB, WS_BBG = 28 * MiB, WS_BBD = 30 * MiB, WS_BOUT = 31 * MiB, WS_BUP = 33 * MiB, WS_BDN = 44 * MiB, WS_BPG = 50 * MiB, WS_BPP = 52 * MiB;
constexpr size_t WS_XB = 64 * MiB, WS_PEB = 98 * MiB, WS_GLR = 107 * MiB, WS_DC = 109 * MiB, WS_LSE = 110 * MiB;
constexpr size_t WS_H = 128 * MiB, WS_LBUF = 452 * MiB, WS_SBUF = 484 * MiB, WS_OAT = 500 * MiB, WS_OD = 552 * MiB, WS_OG = 570 * MiB;
constexpr size_t WS_T = 604 * MiB, WS_MB = 672 * MiB, WS_R = 706 * MiB, WS_X1 = 774 * MiB, WS_X1B = 842 * MiB, WS_AB = 876 * MiB, WS_HM = 970 * MiB;
constexpr size_t WS_X2 = 1064 * MiB, WS_X2B = 1132 * MiB, WS_PP = 1166 * MiB, WS_END = 1234 * MiB;
static_assert(WS_BIN + (size_t)NIN * DM * 2 <= WS_BBG && WS_H + (size_t)MROWS * HLD * 2 <= WS_LBUF && WS_AB + (size_t)MROWS * FF * 2 <= WS_HM && WS_HM + (size_t)MROWS * FF * 2 <= WS_X2, "ws map");
constexpr int CW_BAR = 4096;

constexpr size_t OFF_Y = 0, OFF_GSP = 17825792, OFF_GSS = 18087936, OFF_CP = 34865152, OFF_CS = 34876416;
constexpr size_t OFF_KVP0 = 35597312, OFF_KVP1 = 35859456, OFF_KVP2 = 36908032, OFF_KVS0 = 41102336, OFF_KVS1 = 42150912, OFF_KVS2 = 43199488, OUT_TOTAL = 44248064;

constexpr int LDS_BYTES = 159744;
constexpr int LDS_MISC = 158720;

__device__ __forceinline__ unsigned pkbf(float lo, float hi) { f32x2 v = {lo, hi}; bf16x2v b = __builtin_convertvector(v, bf16x2v); return __builtin_bit_cast(unsigned, b); }
__device__ __forceinline__ bf16 f2bf(float x) { return (bf16)(pkbf(x, 0.f) & 0xffffu); }
__device__ __forceinline__ float bf2f(bf16 v) { return __uint_as_float((unsigned)v << 16); }
__device__ __forceinline__ float bflo(unsigned w) { return __uint_as_float(w << 16); }
__device__ __forceinline__ float bfhi(unsigned w) { return __uint_as_float(w & 0xffff0000u); }
__device__ __forceinline__ float sigm(float x) { return 1.0f / (1.0f + __expf(-x)); }
__device__ __forceinline__ float logsig16(float z) { return (fminf(z, 0.f) - __logf(1.0f + __expf(-fabsf(z)))) * 0.0625f; }
#define MFMA16(a, b, c) __builtin_amdgcn_mfma_f32_16x16x32_bf16((a), (b), (c), 0, 0, 0)
__device__ __forceinline__ bf16x8 ld_tr(const LAS unsigned char* base, int pitch, int k0, int colbyte0, int lane) {
    const int g = lane >> 4, q = (lane & 15) >> 2, p = lane & 3;
    const LAS unsigned char* a0 = base + (k0 + 8 * g + q) * pitch + colbyte0 + 8 * p;
    const v4s lo = __builtin_amdgcn_ds_read_tr16_b64_v4i16((LAS v4s*)a0);
    const v4s hi = __builtin_amdgcn_ds_read_tr16_b64_v4i16((LAS v4s*)(a0 + 4 * pitch));
    return (bf16x8){lo[0], lo[1], lo[2], lo[3], hi[0], hi[1], hi[2], hi[3]};
}
__device__ __forceinline__ bf16x8 pack8(const f32x4 a, const f32x4 b) {
    u32x4 w; w.x = pkbf(a[0], a[1]); w.y = pkbf(a[2], a[3]); w.z = pkbf(b[0], b[1]); w.w = pkbf(b[2], b[3]); return __builtin_bit_cast(bf16x8, w);
}

namespace pg8 {
template <class F> __device__ __forceinline__ void epi_drive(const F& f, const f32x4 (&acc)[2][2][4][2], const f32x4 (&accx)[2], const Unit& u, int wr, int wc, int fr, int fq) {
    const int rowb = u.pm * BM + wr * 64 + fr, cb = wc * 32 + 8 * fq;
#pragma unroll
    for (int ai = 0; ai < 2; ++ai)
#pragma unroll
        for (int m = 0; m < 4; ++m)
#pragma unroll
            for (int bj = 0; bj < 2; ++bj) f.template elem<false>(rowb + ai * HALF + m * 16, u.pn, bj * HALF + cb, acc[ai][bj][m][0], acc[ai][bj][m][1]);
    f.template elem<true>(MP + 16 * u.pm + fr, u.pn, wr * HALF + cb, accx[0], accx[1]);
}
#define EPI_OP() __device__ __forceinline__ void operator()(const f32x4 (&acc)[2][2][4][2], const f32x4 (&accx)[2], const Unit& u, int wr, int wc, int fr, int fq) const { epi_drive(*this, acc, accx, u, wr, wc, fr, fq); }
__device__ __forceinline__ void st_bf8(bf16_t* p, const f32x4 v0, const f32x4 v1) { u32x4 w; w.x = pkbf(v0[0], v0[1]); w.y = pkbf(v0[2], v0[3]); w.z = pkbf(v1[0], v1[1]); w.w = pkbf(v1[2], v1[3]); *(u32x4*)p = w; }
__device__ __forceinline__ void ld_bf8(const bf16_t* p, f32x4& a, f32x4& b) { const u32x4 w = *(const u32x4*)p; a = (f32x4){bflo(w.x), bfhi(w.x), bflo(w.y), bfhi(w.y)}; b = (f32x4){bflo(w.z), bfhi(w.z), bflo(w.w), bfhi(w.w)}; }
struct EpiIn {
    static constexpr bool PERM = true;
    bf16_t* H; float* GLR; const float* rcos; const float* rsin; float* out;
    template <bool SAMPLE> __device__ __forceinline__ void elem(int row, int pn, int cc, f32x4 v0, f32x4 v1) const {
        if (pn == 38) { if (cc < 16) { float* gp = GLR + (size_t)row * 16 + cc; *(f32x4*)gp = v0; *(f32x4*)(gp + 4) = v1; } return; }
        const int mode = pn < 2 ? 0 : pn < 8 ? 1 : pn < 12 ? 2 : pn < 18 ? 3 : pn < 24 ? 4 : pn < 30 ? 5 : 6;
        bf16_t* hp = H + (size_t)row * HLD + pn * BM + cc;
        if (mode == 0) { v0 = v0 * QSCALE_GLA; v1 = v1 * QSCALE_GLA; }
        else if (mode == 2) {
#pragma unroll
            for (int e = 0; e < 4; ++e) { v0[e] = v0[e] * sigm(v0[e]); v1[e] = v1[e] * sigm(v1[e]); }
        } else if (mode == 6) {
#pragma unroll
            for (int e = 0; e < 4; ++e) { v0[e] = sigm(v0[e]); v1[e] = sigm(v1[e]); }
        } else if (mode >= 3) {
            const int t = SAMPLE ? (row & 7) : (row & 8191);
            const int pos = SAMPLE ? 8192 + t : t;
            const int bidx = SAMPLE ? ((row - MP) >> 3) : (row >> 13);
            const int kvsel = (mode == 5) ? 1 : 0;
            const int pnr = (mode == 5) ? pn - 24 : pn - 18;
            const int g = pnr >> 1, W = 128 << (2 * g);
            const int hh = (pnr & 1) * 4 + (cc >> 6);
            float* kvp = nullptr;
            if (mode != 3) {
                if (SAMPLE) kvp = out + ((g == 0) ? OFF_KVS0 : (g == 1) ? OFF_KVS1 : OFF_KVS2) + ((size_t)(bidx * 8 + t) * 2 + kvsel) * 512;
                else if (t >= 8192 - W) kvp = out + ((g == 0) ? OFF_KVP0 : (g == 1) ? OFF_KVP1 : OFF_KVP2) + ((size_t)(bidx * W + (t - (8192 - W))) * 2 + kvsel) * 512;
            }
            if (mode == 5) { if (kvp) { float* o = kvp + hh * 64 + (cc & 63); *(f32x4*)o = v0; *(f32x4*)(o + 4) = v1; } }
            else {
                const int i0 = (cc & 63) >> 1;
                const f32x4 cs = *(const f32x4*)(rcos + pos * 32 + i0), sn = *(const f32x4*)(rsin + pos * 32 + i0);
                const f32x4 x1 = {v0[0], v0[2], v1[0], v1[2]}, x2 = {v0[1], v0[3], v1[1], v1[3]};
                f32x4 y1 = x1 * cs - x2 * sn, y2 = x2 * cs + x1 * sn;
                if (mode == 4) { if (kvp) { float* o = kvp + hh * 64 + i0; *(f32x4*)o = y1; *(f32x4*)(o + 32) = y2; } }
                else { y1 = y1 * QSCALE_DIL; y2 = y2 * QSCALE_DIL; }
                v0 = (f32x4){y1[0], y2[0], y1[1], y2[1]}; v1 = (f32x4){y1[2], y2[2], y1[3], y2[3]};
            }
        }
        st_bf8(hp, v0, v1);
    }
    EPI_OP()
};
struct EpiGateT {
    static constexpr bool PERM = true;
    const bf16_t* G; int gld; float* T;
    template <bool SAMPLE> __device__ __forceinline__ void elem(int row, int pn, int cc, f32x4 v0, f32x4 v1) const {
        const int c = pn * BM + cc; f32x4 g0, g1; ld_bf8(G + (size_t)row * gld + c, g0, g1);
        float* tp = T + (size_t)row * DM + c; *(f32x4*)tp = v0 * g0; *(f32x4*)(tp + 4) = v1 * g1;
    }
    EPI_OP()
};
struct EpiGateM {
    static constexpr bool PERM = true;
    const bf16_t* G; int gld; const float* T; bf16_t* O;
    template <bool SAMPLE> __device__ __forceinline__ void elem(int row, int pn, int cc, f32x4 v0, f32x4 v1) const {
        const int c = pn * BM + cc; f32x4 g0, g1; ld_bf8(G + (size_t)row * gld + c, g0, g1);
        const float* tp = T + (size_t)row * DM + c; const f32x4 t0 = *(const f32x4*)tp, t1 = *(const f32x4*)(tp + 4);
        st_bf8(O + (size_t)row * DM + c, t0 + v0 * g0, t1 + v1 * g1);
    }
    EPI_OP()
};
struct EpiRes {
    static constexpr bool PERM = true;
    const float* resP; const float* resS; float* R;
    template <bool SAMPLE> __device__ __forceinline__ void elem(int row, int pn, int cc, f32x4 v0, f32x4 v1) const {
        const int c = pn * BM + cc; const float* xp = (SAMPLE ? resS + (size_t)(row - MP) * DM : resP + (size_t)row * DM) + c;
        const f32x4 x0 = *(const f32x4*)xp, x1 = *(const f32x4*)(xp + 4);
        float* rp = R + (size_t)row * DM + c; *(f32x4*)rp = x0 * ALPHA + v0; *(f32x4*)(rp + 4) = x1 * ALPHA + v1;
    }
    EPI_OP()
};
struct EpiF32 {
    static constexpr bool PERM = true;
    float* O;
    template <bool SAMPLE> __device__ __forceinline__ void elem(int row, int pn, int cc, f32x4 v0, f32x4 v1) const { float* rp = O + (size_t)row * DM + pn * BM + cc; *(f32x4*)rp = v0; *(f32x4*)(rp + 4) = v1; }
    EPI_OP()
};
struct EpiPle {
    static constexpr bool PERM = true;
    const float* X2; const float* PP; float* R;
    template <bool SAMPLE> __device__ __forceinline__ void elem(int row, int pn, int cc, f32x4 a0, f32x4 a1) const {
        const size_t o = (size_t)row * DM + pn * BM + cc;
        const f32x4 x0 = *(const f32x4*)(X2 + o), x1 = *(const f32x4*)(X2 + o + 4), p0 = *(const f32x4*)(PP + o), p1 = *(const f32x4*)(PP + o + 4);
#pragma unroll
        for (int e = 0; e < 4; ++e) { a0[e] = sigm(a0[e]); a1[e] = sigm(a1[e]); }
        *(f32x4*)(R + o) = x0 * ALPHA + a0 * p0; *(f32x4*)(R + o + 4) = x1 * ALPHA + a1 * p1;
    }
    EPI_OP()
};
struct EpiA {
    static constexpr bool PERM = true;
    bf16_t* AB; float* out;
    template <bool SAMPLE> __device__ __forceinline__ void elem(int row, int pn, int cc, f32x4 v0, f32x4 v1) const {
        const int c = pn * BM + cc; float* cp = nullptr;
        if (SAMPLE) { const int t = row & 7; if (t >= 6) cp = out + OFF_CS + ((size_t)((row - MP) >> 3) * 2 + (t - 6)) * FF; }
        else { const int t = row & 8191; if (t >= 8190) cp = out + OFF_CP + ((size_t)(row >> 13) * 2 + (t - 8190)) * FF; }
        if (cp) { *(f32x4*)(cp + c) = v0; *(f32x4*)(cp + c + 4) = v1; }
        st_bf8(AB + (size_t)row * FF + c, v0, v1);
    }
    EPI_OP()
};
struct EpiU {
    static constexpr bool PERM = true;
    const bf16_t* AB; const float* cprev; const float* cw; const float* cbias; bf16_t* HM;
    struct CW { f32x4 w0a, w0b, w1a, w1b, w2a, w2b, cba, cbb; };
    __device__ __forceinline__ CW ldw(int c) const { CW q; q.w0a = *(const f32x4*)(cw + c); q.w0b = *(const f32x4*)(cw + c + 4); q.w1a = *(const f32x4*)(cw + FF + c); q.w1b = *(const f32x4*)(cw + FF + c + 4);
        q.w2a = *(const f32x4*)(cw + 2 * FF + c); q.w2b = *(const f32x4*)(cw + 2 * FF + c + 4); q.cba = *(const f32x4*)(cbias + c); q.cbb = *(const f32x4*)(cbias + c + 4); return q; }
    template <bool SAMPLE> __device__ __forceinline__ void elem(int row, int c, const CW& q, const f32x4 u0, const f32x4 u1) const {
        const int t = SAMPLE ? (row & 7) : (row & 8191);
        f32x4 a0a, a0b, a1a = {0.f, 0.f, 0.f, 0.f}, a1b = a1a, a2a = a1a, a2b = a1a;
        ld_bf8(AB + (size_t)row * FF + c, a0a, a0b);
        if (t >= 1) ld_bf8(AB + (size_t)(row - 1) * FF + c, a1a, a1b);
        else if (SAMPLE) { const float* p = cprev + ((size_t)((row - MP) >> 3) * 2 + 1) * FF + c; a1a = *(const f32x4*)p; a1b = *(const f32x4*)(p + 4); }
        if (t >= 2) ld_bf8(AB + (size_t)(row - 2) * FF + c, a2a, a2b);
        else if (SAMPLE) { const float* p = cprev + ((size_t)((row - MP) >> 3) * 2 + t) * FF + c; a2a = *(const f32x4*)p; a2b = *(const f32x4*)(p + 4); }
        const f32x4 ca = q.cba + q.w0a * a2a + q.w1a * a1a + q.w2a * a0a, cbv = q.cbb + q.w0b * a2b + q.w1b * a1b + q.w2b * a0b;
        const f32x2 g0 = gelu_pk((f32x2){ca[0], ca[1]}), g1 = gelu_pk((f32x2){ca[2], ca[3]}), g2 = gelu_pk((f32x2){cbv[0], cbv[1]}), g3 = gelu_pk((f32x2){cbv[2], cbv[3]});
        u32x4 w; w.x = pkbf(g0.x * u0[0], g0.y * u0[1]); w.y = pkbf(g1.x * u0[2], g1.y * u0[3]); w.z = pkbf(g2.x * u1[0], g2.y * u1[1]); w.w = pkbf(g3.x * u1[2], g3.y * u1[3]);
        *(u32x4*)(HM + (size_t)row * FF + c) = w;
    }
    __device__ __forceinline__ void operator()(const f32x4 (&acc)[2][2][4][2], const f32x4 (&accx)[2], const Unit& u, int wr, int wc, int fr, int fq) const {
        const int rowb = u.pm * BM + wr * 64 + fr, col0 = u.pn * BM + wc * 32 + 8 * fq;
#pragma unroll
        for (int bj = 0; bj < 2; ++bj) {
            const CW q = ldw(col0 + bj * HALF);
#pragma unroll
            for (int ai = 0; ai < 2; ++ai)
#pragma unroll
                for (int m = 0; m < 4; ++m) elem<false>(rowb + ai * HALF + m * 16, col0 + bj * HALF, q, acc[ai][bj][m][0], acc[ai][bj][m][1]);
            if (bj == wr) elem<true>(MP + 16 * u.pm + fr, col0 + bj * HALF, q, accx[0], accx[1]);
        }
    }
};
#undef EPI_OP
}

__device__ const float kRopeInv[32] = {
    1.000000000e+00f, 7.498942614e-01f, 5.623413324e-01f, 4.216965139e-01f, 3.162277639e-01f, 2.371373773e-01f, 1.778279394e-01f, 1.333521307e-01f,
    1.000000015e-01f, 7.498941571e-02f, 5.623413250e-02f, 4.216965288e-02f, 3.162277490e-02f, 2.371373773e-02f, 1.778279431e-02f, 1.333521493e-02f,
    9.999999776e-03f, 7.498941850e-03f, 5.623413250e-03f, 4.216964822e-03f, 3.162277630e-03f, 2.371373586e-03f, 1.778279431e-03f, 1.333521446e-03f,
    1.000000047e-03f, 7.498942432e-04f, 5.623413017e-04f, 4.216965172e-04f, 3.162277571e-04f, 2.371373703e-04f, 1.778279402e-04f, 1.333521504e-04f};

__device__ __forceinline__ int win_dst(int ns) {
    if (ns < 3072) return ns;
    if (ns < 3088) return 9728 + (ns - 3072);
    const int c = ns - 16;
    if (c < 6144) { const int hb = c & ~63, d = c & 63; return hb + 2 * (d & 31) + (d >> 5); }
    return c;
}
template <bool MAPIN>
__device__ __forceinline__ void transpose_item(const float* W, int K, int N, bf16* WT, LAS float* scr, int item, int lane) {
    const int nblk = (N + 31) / 32, kb = item / nblk, nb = item % nblk, k0 = 64 * kb, n0 = 32 * nb;
    const bool okr = (n0 + (lane & 31)) < N;
#pragma unroll 8
    for (int i = 0; i < 32; ++i) { const int kk = 2 * i + (lane >> 5); scr[kk * 33 + (lane & 31)] = okr ? W[(size_t)(k0 + kk) * N + n0 + (lane & 31)] : 0.f; }
    asm volatile("s_waitcnt lgkmcnt(0)" ::: "memory");
    const int c = lane & 7;
#pragma unroll
    for (int j = 0; j < 4; ++j) { const int n = (lane >> 3) + 8 * j; const LAS float* s = scr + (8 * c) * 33 + n;
        u32x4 o; o.x = pkbf(s[0 * 33], s[1 * 33]); o.y = pkbf(s[2 * 33], s[3 * 33]); o.z = pkbf(s[4 * 33], s[5 * 33]); o.w = pkbf(s[6 * 33], s[7 * 33]);
        const int ns = n0 + n;
        if (ns < N) { const int dr = MAPIN ? win_dst(ns) : ns; *(u32x4*)(WT + (size_t)dr * K + k0 + 8 * c) = o; } }
    asm volatile("s_waitcnt lgkmcnt(0)" ::: "memory");
}
__device__ __forceinline__ void row_to_bf16(const float* src, bf16* dst, int ncol, int lane) {
    for (int c = lane * 4; c < ncol; c += 256) { const f32x4 v = *(const f32x4*)(src + c); u32x2 w; w.x = pkbf(v[0], v[1]); w.y = pkbf(v[2], v[3]); *(u32x2*)(dst + c) = w; }
}
__device__ __forceinline__ void ln_pass(const float* R, const float* gam, const float* bet, float* of32, bf16* obf, int gw, int ngw, int lane) {
    f32x4 gv[4], bv[4];
#pragma unroll
    for (int j = 0; j < 4; ++j) { gv[j] = *(const f32x4*)(gam + 4 * lane + 256 * j); bv[j] = *(const f32x4*)(bet + 4 * lane + 256 * j); }
    for (int row = gw; row < MROWS; row += ngw) {
        const float* xr = R + (size_t)row * DM + 4 * lane;
        f32x4 v[4]; float s = 0.f;
#pragma unroll
        for (int j = 0; j < 4; ++j) { v[j] = *(const f32x4*)(xr + 256 * j); s += (v[j][0] + v[j][1]) + (v[j][2] + v[j][3]); }
#pragma unroll
        for (int o = 1; o < 64; o <<= 1) s += __shfl_xor(s, o);
        const float mean = s * (1.f / DM); float s2 = 0.f;
#pragma unroll
        for (int j = 0; j < 4; ++j) { v[j] = v[j] - mean; s2 += (v[j][0] * v[j][0] + v[j][1] * v[j][1]) + (v[j][2] * v[j][2] + v[j][3] * v[j][3]); }
#pragma unroll
        for (int o = 1; o < 64; o <<= 1) s2 += __shfl_xor(s2, o);
        const float rstd = 1.0f / sqrtf(s2 * (1.f / DM) + LN_EPS);
#pragma unroll
        for (int j = 0; j < 4; ++j) { const f32x4 y = v[j] * rstd * gv[j] + bv[j];
            if (of32) *(f32x4*)(of32 + (size_t)row * DM + 4 * lane + 256 * j) = y;
            if (obf) { u32x2 w; w.x = pkbf(y[0], y[1]); w.y = pkbf(y[2], y[3]); *(u32x2*)(obf + (size_t)row * DM + 4 * lane + 256 * j) = w; } }
    }
}

constexpr int AT_PITCH = 144, AT_VOFF = 272 * 144;
__device__ __forceinline__ void attn_softmax(f32x4 (&sc)[5][2], int kbase, int kq, int klo, int khi, int g4, bf16x8 (&pf)[5], float& lsum, float& mx) {
    float m = -INFINITY;
#pragma unroll
    for (int ks = 0; ks < 5; ++ks)
#pragma unroll
        for (int be = 0; be < 2; ++be)
#pragma unroll
            for (int i = 0; i < 4; ++i) { const int key = kbase + 32 * ks + 8 * g4 + 4 * be + i; const bool ok = (key <= kq) && (key + 128 >= kq) && (key >= klo) && (key < khi);
                const float s = ok ? sc[ks][be][i] : -INFINITY; sc[ks][be][i] = s; m = fmaxf(m, s); }
    m = fmaxf(m, __shfl_xor(m, 16)); m = fmaxf(m, __shfl_xor(m, 32));
    float l = 0.f;
#pragma unroll
    for (int ks = 0; ks < 5; ++ks) {
#pragma unroll
        for (int be = 0; be < 2; ++be)
#pragma unroll
            for (int i = 0; i < 4; ++i) { const float p = __builtin_amdgcn_exp2f(sc[ks][be][i] - m); sc[ks][be][i] = p; l += p; }
        pf[ks] = pack8(sc[ks][0], sc[ks][1]);
    }
    l += __shfl_xor(l, 16); l += __shfl_xor(l, 32);
    lsum = l; mx = m;
}

struct AttnU { int g, b, h, c, qb, r; };
__device__ __forceinline__ AttnU attn_decode_unit_id(int unit) {
    AttnU u; u.g = unit >> 10; const int rem = unit & 1023; u.b = rem >> 9; const int rem2 = rem & 511; u.h = rem2 >> 6; const int x = rem2 & 63;
    const int sh = 2 * u.g; u.r = 1 << sh; const int nqb = 64 >> sh; u.c = x / nqb; u.qb = x % nqb; return u;
}
__device__ __forceinline__ void attn_tile_fetch(const AttnU& u, const bf16* H, int tid, int lane, int wid, u32x4 (&tv)[8], bf16x8& qf0, bf16x8& qf1) {
    const int rowbase = u.b * TP, jk0 = 128 * u.qb - 128;
    const int colk = C_DK + u.g * 512 + u.h * 64, colv = C_DV + u.g * 512 + u.h * 64, colq = C_DQ + u.g * 512 + u.h * 64;
#pragma unroll
    for (int i = 0; i < 8; ++i) {
        const int p = tid + 512 * i, kv = p >> 11, rr = (p & 2047) >> 3, pc = p & 7;
        const int jk = jk0 + rr;
        u32x4 val = {0u, 0u, 0u, 0u};
        if (jk >= 0) val = *(const u32x4*)(H + (size_t)(rowbase + jk * u.r + u.c) * HLD + (kv ? colv : colk) + pc * 8);
        tv[i] = val;
    }
    const int jq = 128 * u.qb + 16 * wid + (lane & 15);
    const bf16* qp = H + (size_t)(rowbase + jq * u.r + u.c) * HLD + colq + 8 * (lane >> 4);
    qf0 = *(const bf16x8*)qp; qf1 = *(const bf16x8*)(qp + 32);
}
__device__ __forceinline__ void attn_tile_store(LAS unsigned char* buf, int tid, const u32x4 (&tv)[8]) {
#pragma unroll
    for (int i = 0; i < 8; ++i) { const int p = tid + 512 * i, kv = p >> 11, rr = (p & 2047) >> 3, pc = p & 7; *(LAS u32x4*)(buf + (kv ? AT_VOFF : 0) + rr * AT_PITCH + pc * 16) = tv[i]; }
}
constexpr int AT_BUF = 2 * 272 * 144;
__device__ __forceinline__ void attn_prompt_phase(LAS unsigned char* lds, int u0, int ustep, int uend, const bf16* H, bf16* OAT, float* LSE, int tid, int lane, int wid) {
    if (u0 >= uend) return;
    { const int bsel = tid >> 8, t2 = tid & 255, kv = t2 >> 7, rr = 256 + ((t2 & 127) >> 3), pc = t2 & 7; *(LAS u32x4*)(lds + bsel * AT_BUF + (kv ? AT_VOFF : 0) + rr * AT_PITCH + pc * 16) = (u32x4){0u, 0u, 0u, 0u}; }
    u32x4 tv[8]; bf16x8 qf0, qf1;
    AttnU cur = attn_decode_unit_id(u0);
    attn_tile_fetch(cur, H, tid, lane, wid, tv, qf0, qf1);
    attn_tile_store(lds, tid, tv);
    int it = 0;
    for (int unit = u0; unit < uend; unit += ustep, ++it) {
        LAS unsigned char* buf = lds + (it & 1) * AT_BUF;
        __syncthreads();
        const bool has_next = (unit + ustep) < uend;
        AttnU nxt = cur; bf16x8 nq0 = qf0, nq1 = qf1;
        if (has_next) { nxt = attn_decode_unit_id(unit + ustep); attn_tile_fetch(nxt, H, tid, lane, wid, tv, nq0, nq1); }
        {
            const int fr = lane & 15, g4 = lane >> 4;
            const int jq = 128 * cur.qb + 16 * wid + fr;
            const size_t qrow = (size_t)(cur.b * TP + jq * cur.r + cur.c);
            f32x4 sc[5][2];
#pragma unroll
            for (int ks = 0; ks < 5; ++ks)
#pragma unroll
                for (int be = 0; be < 2; ++be) {
                    const int krow = 16 * wid + 32 * ks + 8 * (fr >> 2) + 4 * be + (fr & 3);
                    const LAS unsigned char* kp = buf + krow * AT_PITCH + 16 * g4;
                    const bf16x8 k0 = *(const LAS bf16x8*)kp, k1 = *(const LAS bf16x8*)(kp + 64);
                    f32x4 a = {0.f, 0.f, 0.f, 0.f}; a = MFMA16(k0, qf0, a); a = MFMA16(k1, qf1, a); sc[ks][be] = a;
                }
            bf16x8 pf[5]; float l, mx;
            attn_softmax(sc, 16 * wid, 128 + 16 * wid + fr, (cur.qb == 0) ? 128 : 0, 256, g4, pf, l, mx);
            f32x4 oT[4];
#pragma unroll
            for (int db = 0; db < 4; ++db) { oT[db] = (f32x4){0.f, 0.f, 0.f, 0.f};
#pragma unroll
                for (int ks = 0; ks < 5; ++ks) { const bf16x8 vf = ld_tr(buf + AT_VOFF, AT_PITCH, 16 * wid + 32 * ks, 32 * db, lane); oT[db] = MFMA16(vf, pf[ks], oT[db]); } }
            const float il = 1.0f / l;
            bf16* op = OAT + ((size_t)cur.g * MROWS + qrow) * 512 + cur.h * 64 + 4 * g4;
#pragma unroll
            for (int db = 0; db < 4; ++db) { u32x2 w; w.x = pkbf(oT[db][0] * il, oT[db][1] * il); w.y = pkbf(oT[db][2] * il, oT[db][3] * il); *(u32x2*)(op + 16 * db) = w; }
            if (g4 == 0) LSE[((size_t)cur.g * MROWS + qrow) * 8 + cur.h] = mx + __log2f(l);
        }
        if (has_next) attn_tile_store(lds + ((it + 1) & 1) * AT_BUF, tid, tv);
        cur = nxt; qf0 = nq0; qf1 = nq1;
    }
    __syncthreads();
}

__device__ __forceinline__ void attn_dec_unit(LAS unsigned char* lds, int unit, const float* ck0, const float* ck1, const float* ck2, const bf16* H, bf16* OAT, float* LSE, int lane, int wid) {
    int g, b, c;
    if (unit < 128) { g = 0; b = unit; c = 0; } else if (unit < 640) { g = 1; b = (unit - 128) >> 2; c = (unit - 128) & 3; } else { g = 2; b = (unit - 640) >> 3; c = (unit - 640) & 7; }
    const int sh = 2 * g, r = 1 << sh, W = 128 << sh, nnew = 8 >> (g == 0 ? 0 : g == 1 ? 2 : 3);
    const int h = wid, fr = lane & 15, g4 = lane >> 4;
    const float* cache = ((g == 0) ? ck0 : (g == 1) ? ck1 : ck2) + (size_t)b * W * 1024 + h * 64;
    const size_t nrow0 = (size_t)MP + 8 * b;
    const int colk = C_DK + g * 512 + h * 64, colv = C_DV + g * 512 + h * 64, colq = C_DQ + g * 512 + h * 64;
    LAS unsigned char* wl = lds + wid * (32 * AT_PITCH);
    const int qi = fr < nnew ? fr : nnew - 1;
    const bf16* qp = H + (nrow0 + c + r * qi) * HLD + colq + 8 * g4;
    const bf16x8 qf0 = *(const bf16x8*)qp, qf1 = *(const bf16x8*)(qp + 32);
    f32x4 sc[5][2];
#pragma unroll
    for (int kh2 = 0; kh2 < 2; ++kh2) {
        f32x4 kl[2][2][4];
#pragma unroll
        for (int k2 = 0; k2 < 2; ++k2)
#pragma unroll
            for (int be = 0; be < 2; ++be) {
                const int key = 32 * (2 * kh2 + k2) + 8 * (fr >> 2) + 4 * be + (fr & 3);
                const float* kp = cache + (size_t)(c + r * key) * 1024 + 4 * g4;
                kl[k2][be][0] = *(const f32x4*)kp; kl[k2][be][1] = *(const f32x4*)(kp + 32); kl[k2][be][2] = *(const f32x4*)(kp + 16); kl[k2][be][3] = *(const f32x4*)(kp + 48);
            }
#pragma unroll
        for (int k2 = 0; k2 < 2; ++k2)
#pragma unroll
            for (int be = 0; be < 2; ++be) {
                const f32x4 lo0 = kl[k2][be][0], hi0 = kl[k2][be][1], lo1 = kl[k2][be][2], hi1 = kl[k2][be][3];
                u32x4 w0, w1;
                w0.x = pkbf(lo0[0], hi0[0]); w0.y = pkbf(lo0[1], hi0[1]); w0.z = pkbf(lo0[2], hi0[2]); w0.w = pkbf(lo0[3], hi0[3]);
                w1.x = pkbf(lo1[0], hi1[0]); w1.y = pkbf(lo1[1], hi1[1]); w1.z = pkbf(lo1[2], hi1[2]); w1.w = pkbf(lo1[3], hi1[3]);
                f32x4 a = {0.f, 0.f, 0.f, 0.f}; a = MFMA16(__builtin_bit_cast(bf16x8, w0), qf0, a); a = MFMA16(__builtin_bit_cast(bf16x8, w1), qf1, a); sc[2 * kh2 + k2][be] = a;
            }
    }
#pragma unroll
    for (int be = 0; be < 2; ++be) {
        const int i = 8 * (fr >> 2) + 4 * be + (fr & 3);
        bf16x8 k0 = {0, 0, 0, 0, 0, 0, 0, 0}, k1 = k0;
        if (i < nnew) { const bf16* kp = H + (nrow0 + c + r * i) * HLD + colk + 8 * g4; k0 = *(const bf16x8*)kp; k1 = *(const bf16x8*)(kp + 32); }
        f32x4 a = {0.f, 0.f, 0.f, 0.f}; a = MFMA16(k0, qf0, a); a = MFMA16(k1, qf1, a); sc[4][be] = a;
    }
    f32x4 vl[2][8];
#pragma unroll
    for (int ks = 0; ks < 2; ++ks)
#pragma unroll
        for (int i = 0; i < 8; ++i) { const int rr = 4 * i + g4; vl[ks][i] = *(const f32x4*)(cache + (size_t)(c + r * (32 * ks + rr)) * 1024 + 512 + 4 * fr); }
    u32x4 vn[4];
#pragma unroll
    for (int i = 0; i < 4; ++i) { const int rr = 8 * i + (lane >> 3), pc = lane & 7; vn[i] = (u32x4){0u, 0u, 0u, 0u};
        if (rr < nnew) vn[i] = *(const u32x4*)(H + (nrow0 + c + r * rr) * HLD + colv + pc * 8); }
    bf16x8 pf[5]; float l, mx;
    attn_softmax(sc, 0, 128 + fr, 0, 128 + nnew, g4, pf, l, mx);
    f32x4 oT[4];
#pragma unroll
    for (int db = 0; db < 4; ++db) oT[db] = (f32x4){0.f, 0.f, 0.f, 0.f};
    f32x4 vl2[2][8];
#pragma unroll
    for (int ks = 0; ks < 2; ++ks)
#pragma unroll
        for (int i = 0; i < 8; ++i) { const int rr = 4 * i + g4; vl2[ks][i] = *(const f32x4*)(cache + (size_t)(c + r * (32 * (ks + 2) + rr)) * 1024 + 512 + 4 * fr); }
#pragma unroll
    for (int ks = 0; ks < 5; ++ks) {
        if (ks < 4) {
#pragma unroll
            for (int i = 0; i < 8; ++i) { const int rr = 4 * i + g4; const f32x4 v = (ks < 2) ? vl[ks & 1][i] : vl2[ks & 1][i];
                u32x2 w; w.x = pkbf(v[0], v[1]); w.y = pkbf(v[2], v[3]); *(LAS u32x2*)(wl + rr * AT_PITCH + fr * 8) = w; }
        } else {
#pragma unroll
            for (int i = 0; i < 4; ++i) { const int rr = 8 * i + (lane >> 3), pc = lane & 7; *(LAS u32x4*)(wl + rr * AT_PITCH + pc * 16) = vn[i]; }
        }
#pragma unroll
        for (int db = 0; db < 4; ++db) { const bf16x8 vf = ld_tr(wl, AT_PITCH, 0, 32 * db, lane); oT[db] = MFMA16(vf, pf[ks], oT[db]); }
    }
    if (fr < nnew) {
        const float il = 1.0f / l;
        const size_t qrow = nrow0 + c + r * fr;
        bf16* op = OAT + ((size_t)g * MROWS + qrow) * 512 + h * 64 + 4 * g4;
#pragma unroll
        for (int db = 0; db < 4; ++db) { u32x2 w; w.x = pkbf(oT[db][0] * il, oT[db][1] * il); w.y = pkbf(oT[db][2] * il, oT[db][3] * il); *(u32x2*)(op + 16 * db) = w; }
        if (g4 == 0) LSE[((size_t)g * MROWS + qrow) * 8 + h] = mx + __log2f(l);
    }
}

constexpr int G1_GLR = 0, G1_PART = 4096, G1_DEC = 6144, G1_K = 8192, G1_KP = 272, G1_V = 8192 + 64 * 272, G1_VP = 528;
__device__ __forceinline__ void g1_unit(LAS unsigned char* lds, int unit, const bf16* H, const float* GLR, const float* wgk, const float* bgk, float* LBUF, float* DC, int tid, int lane, int wid) {
    const int bh = unit >> 5, cch = unit & 31, b = bh >> 2, h = bh & 3;
    const int row0 = b * TP + cch * 256;
    const int ch = tid & 127, sq = tid >> 7;
    float w[16];
#pragma unroll
    for (int r = 0; r < 16; ++r) w[r] = wgk[r * 512 + h * 128 + ch];
    const float bias = bgk[h * 128 + ch];
    f32x4 acc[2][8];
#pragma unroll
    for (int vb = 0; vb < 2; ++vb)
#pragma unroll
        for (int kb = 0; kb < 8; ++kb) acc[vb][kb] = (f32x4){0.f, 0.f, 0.f, 0.f};
    float btot = 0.f;
    for (int j = 0; j < 4; ++j) {
        const int rj = row0 + 64 * j;
        if (tid < 256) *(LAS f32x4*)(lds + G1_GLR + tid * 16) = *(const f32x4*)(GLR + (size_t)rj * 16 + tid * 4);
#pragma unroll
        for (int i = 0; i < 4; ++i) { const int p = tid + 512 * i, rr = p >> 5, pc = p & 31;
            *(LAS u32x4*)(lds + G1_V + rr * G1_VP + pc * 16) = *(const u32x4*)(H + (size_t)(rj + rr) * HLD + C_GV + h * 256 + pc * 8); }
        __syncthreads();
        float ld[16]; float loc = 0.f;
#pragma unroll
        for (int i = 0; i < 16; ++i) {
            const LAS f32x4* gp = (const LAS f32x4*)(lds + G1_GLR + (16 * sq + i) * 64);
            const f32x4 a0 = gp[0], a1 = gp[1], a2 = gp[2], a3 = gp[3];
            float z = bias;
#pragma unroll
            for (int e = 0; e < 4; ++e) { z += a0[e] * w[e]; z += a1[e] * w[4 + e]; z += a2[e] * w[8 + e]; z += a3[e] * w[12 + e]; }
            ld[i] = logsig16(z); loc += ld[i];
        }
        *(LAS float*)(lds + G1_PART + (sq * 128 + ch) * 4) = loc;
        __syncthreads();
        const float p0 = *(const LAS float*)(lds + G1_PART + ch * 4), p1 = *(const LAS float*)(lds + G1_PART + (128 + ch) * 4);
        const float p2 = *(const LAS float*)(lds + G1_PART + (256 + ch) * 4), p3 = *(const LAS float*)(lds + G1_PART + (384 + ch) * 4);
        const float tot = (p0 + p1) + (p2 + p3);
        float bb = (sq > 0 ? p0 : 0.f) + (sq > 1 ? p1 : 0.f) + (sq > 2 ? p2 : 0.f);
#pragma unroll
        for (int i = 0; i < 16; ++i) {
            bb += ld[i];
            const float kv = bf2f(H[(size_t)(rj + 16 * sq + i) * HLD + C_GK + h * 128 + ch]);
            *(LAS bf16*)(lds + G1_K + (16 * sq + i) * G1_KP + ch * 2) = f2bf(kv * __expf(tot - bb));
        }
        if (sq == 0) *(LAS float*)(lds + G1_DEC + ch * 4) = __expf(tot);
        btot += tot;
        __syncthreads();
        if (j > 0) {
#pragma unroll
            for (int kb = 0; kb < 8; ++kb) { const float d = *(const LAS float*)(lds + G1_DEC + (16 * kb + (lane & 15)) * 4);
#pragma unroll
                for (int vb = 0; vb < 2; ++vb) acc[vb][kb] = acc[vb][kb] * d; }
        }
#pragma unroll
        for (int s2 = 0; s2 < 2; ++s2) {
            bf16x8 af[2];
#pragma unroll
            for (int vb = 0; vb < 2; ++vb) af[vb] = ld_tr(lds + G1_V, G1_VP, 32 * s2, (32 * wid + 16 * vb) * 2, lane);
#pragma unroll
            for (int kb = 0; kb < 8; ++kb) { const bf16x8 bfr = ld_tr(lds + G1_K, G1_KP, 32 * s2, 32 * kb, lane);
#pragma unroll
                for (int vb = 0; vb < 2; ++vb) acc[vb][kb] = MFMA16(af[vb], bfr, acc[vb][kb]); }
        }
        __syncthreads();
    }
    float* lb = LBUF + (size_t)unit * 256 * 128;
#pragma unroll
    for (int vb = 0; vb < 2; ++vb)
#pragma unroll
        for (int kb = 0; kb < 8; ++kb)
#pragma unroll
            for (int i = 0; i < 4; ++i) lb[(size_t)(32 * wid + 16 * vb + 4 * (lane >> 4) + i) * 128 + 16 * kb + (lane & 15)] = acc[vb][kb][i];
    if (sq == 0) DC[unit * 128 + ch] = __expf(btot);
}

constexpr int GS_COEF = 0, GS_QB = 12288, GS_KB = 16384, GS_A = 20480, GS_VV = 20736, GS_OP = 28928, GS_RED = 45312;
__device__ __forceinline__ void gla_sample_unit(LAS unsigned char* lds, int unit, const bf16* H, const float* GLR, const float* wgk, const float* bgk, const float* state, const float* gnorm,
                                                float* out, bf16* OG, int tid, int lane, int wid) {
    const int b = unit >> 2, h = unit & 3;
    const size_t row0 = (size_t)MP + 8 * b;
    LAS float* coef = (LAS float*)(lds + GS_COEF);
    LAS float* qb = (LAS float*)(lds + GS_QB);
    LAS float* kb = (LAS float*)(lds + GS_KB);
    LAS float* Am = (LAS float*)(lds + GS_A);
    LAS float* vv = (LAS float*)(lds + GS_VV);
    LAS float* op = (LAS float*)(lds + GS_OP);
    LAS float* red = (LAS float*)(lds + GS_RED);
    if (tid < 128) {
        const int ch = tid;
        float bt[8]; float bc = 0.f;
        const float bias = bgk[h * 128 + ch];
        float w[16];
#pragma unroll
        for (int r = 0; r < 16; ++r) w[r] = wgk[r * 512 + h * 128 + ch];
#pragma unroll
        for (int t = 0; t < 8; ++t) { const float* gp = GLR + (row0 + t) * 16; float z = bias;
#pragma unroll
            for (int r = 0; r < 16; ++r) z += gp[r] * w[r];
            bc += logsig16(z); bt[t] = bc; }
#pragma unroll
        for (int t = 0; t < 8; ++t) {
            const float qv = bf2f(H[(row0 + t) * HLD + C_GQ + h * 128 + ch]), kv = bf2f(H[(row0 + t) * HLD + C_GK + h * 128 + ch]);
            const float e = __expf(bt[t]);
            coef[ch * 24 + t] = qv * e; coef[ch * 24 + 8 + t] = kv * __expf(bt[7] - bt[t]);
            qb[t * 128 + ch] = qv * e; kb[t * 128 + ch] = kv * __expf(-bt[t]);
        }
        coef[ch * 24 + 16] = __expf(bt[7]);
    }
#pragma unroll
    for (int i = 0; i < 4; ++i) { const int idx = tid + 512 * i, s = idx >> 8, v = idx & 255; vv[idx] = bf2f(H[(row0 + s) * HLD + C_GV + h * 256 + v]); }
    __syncthreads();
    { const int pair = tid >> 3, part = tid & 7, t = pair >> 3, s2 = pair & 7; float a = 0.f;
#pragma unroll
      for (int k = 0; k < 16; ++k) a += qb[t * 128 + part * 16 + k] * kb[s2 * 128 + part * 16 + k];
      a += __shfl_xor(a, 1); a += __shfl_xor(a, 2); a += __shfl_xor(a, 4);
      if (part == 0) Am[pair] = (s2 <= t) ? a : 0.f; }
    {
        const int v = tid & 255, kh = tid >> 8;
        float o[8], vs[8];
#pragma unroll
        for (int t = 0; t < 8; ++t) { o[t] = 0.f; vs[t] = vv[t * 256 + v]; }
        const float* S0 = state + ((size_t)(b * 4 + h) * 128 + kh * 64) * 256 + v;
        float* S1 = out + OFF_GSS + ((size_t)(b * 4 + h) * 128 + kh * 64) * 256 + v;
        float s0v[64];
#pragma unroll
        for (int kk = 0; kk < 64; ++kk) s0v[kk] = S0[(size_t)kk * 256];
#pragma unroll
        for (int kk = 0; kk < 64; ++kk) {
            const int k = kh * 64 + kk;
            const float s0 = s0v[kk];
            const LAS f32x4* cp = (const LAS f32x4*)(coef + k * 24);
            const f32x4 c0 = cp[0], c1 = cp[1], c2 = cp[2], c3 = cp[3]; const float d7 = coef[k * 24 + 16];
            o[0] += c0[0] * s0; o[1] += c0[1] * s0; o[2] += c0[2] * s0; o[3] += c0[3] * s0; o[4] += c1[0] * s0; o[5] += c1[1] * s0; o[6] += c1[2] * s0; o[7] += c1[3] * s0;
            float sn = d7 * s0;
            sn += c2[0] * vs[0]; sn += c2[1] * vs[1]; sn += c2[2] * vs[2]; sn += c2[3] * vs[3]; sn += c3[0] * vs[4]; sn += c3[1] * vs[5]; sn += c3[2] * vs[6]; sn += c3[3] * vs[7];
            S1[(size_t)kk * 256] = sn;
        }
#pragma unroll
        for (int t = 0; t < 8; ++t) op[(kh * 8 + t) * 256 + v] = o[t];
    }
    __syncthreads();
    float o[8];
    {
        const int v = tid & 255;
#pragma unroll
        for (int t = 0; t < 8; ++t) { float a = op[t * 256 + v] + op[(8 + t) * 256 + v];
#pragma unroll
            for (int s = 0; s < 8; ++s) if (s <= t) a += Am[t * 8 + s] * vv[s * 256 + v];
            o[t] = a; }
        if (tid < 256) {
#pragma unroll
            for (int t = 0; t < 8; ++t) { float q = o[t] * o[t];
#pragma unroll
                for (int of = 1; of < 64; of <<= 1) q += __shfl_xor(q, of);
                if (lane == 0) red[wid * 8 + t] = q; }
        }
    }
    __syncthreads();
    if (tid < 256) {
        const int v = tid;
        const float gn = gnorm[v];
#pragma unroll
        for (int t = 0; t < 8; ++t) {
            const float ss = (red[t] + red[8 + t]) + (red[16 + t] + red[24 + t]);
            const float rs = 1.0f / sqrtf(ss * (1.f / 256.f) + LN_EPS);
            const float gg = bf2f(H[(row0 + t) * HLD + C_GG + h * 256 + v]);
            OG[(row0 + t) * DM + h * 256 + v] = f2bf(o[t] * rs * gn * gg);
        }
    }
    __syncthreads();
}

constexpr int G3_R0 = 0, G3_R1 = 69632, G3_P = 272, G3_GLR = 139264, G3_PART = 155648, G3_VP = 528;
__device__ __forceinline__ void g3_unit(LAS unsigned char* lds, int unit, const bf16* H, const float* GLR, const float* wgk, const float* bgk, const bf16* SBUF, const float* gnorm, bf16* OG,
                                        int tid, int lane, int wid) {
    const int bh = unit >> 5, cch = unit & 31, b = bh >> 2, h = bh & 3;
    const int row0 = b * TP + cch * 256;
    const int ch = tid & 127, qt = tid >> 7;
#pragma unroll
    for (int i = 0; i < 2; ++i) { const int idx = tid + 512 * i; *(LAS f32x4*)(lds + G3_GLR + idx * 16) = *(const f32x4*)(GLR + (size_t)row0 * 16 + idx * 4); }
    float w[16];
#pragma unroll
    for (int r = 0; r < 16; ++r) w[r] = wgk[r * 512 + h * 128 + ch];
    const float bias = bgk[h * 128 + ch];
    __syncthreads();
    float loc = 0.f;
#pragma unroll 4
    for (int i = 0; i < 64; ++i) {
        const LAS f32x4* gp = (const LAS f32x4*)(lds + G3_GLR + (64 * qt + i) * 64);
        const f32x4 a0 = gp[0], a1 = gp[1], a2 = gp[2], a3 = gp[3];
        float z = bias;
#pragma unroll
        for (int e = 0; e < 4; ++e) { z += a0[e] * w[e]; z += a1[e] * w[4 + e]; z += a2[e] * w[8 + e]; z += a3[e] * w[12 + e]; }
        loc += logsig16(z);
    }
    *(LAS float*)(lds + G3_PART + (qt * 128 + ch) * 4) = loc;
    __syncthreads();
    {
        const float p0 = *(const LAS float*)(lds + G3_PART + ch * 4), p1 = *(const LAS float*)(lds + G3_PART + (128 + ch) * 4), p2 = *(const LAS float*)(lds + G3_PART + (256 + ch) * 4);
        float bb = (qt > 0 ? p0 : 0.f) + (qt > 1 ? p1 : 0.f) + (qt > 2 ? p2 : 0.f);
#pragma unroll 4
        for (int i = 0; i < 64; ++i) {
            const LAS f32x4* gp = (const LAS f32x4*)(lds + G3_GLR + (64 * qt + i) * 64);
            const f32x4 a0 = gp[0], a1 = gp[1], a2 = gp[2], a3 = gp[3];
            float z = bias;
#pragma unroll
            for (int e = 0; e < 4; ++e) { z += a0[e] * w[e]; z += a1[e] * w[4 + e]; z += a2[e] * w[8 + e]; z += a3[e] * w[12 + e]; }
            bb += logsig16(z);
            const size_t rr = (size_t)(row0 + 64 * qt + i) * HLD + h * 128 + ch;
            const float qv = bf2f(H[rr + C_GQ]), kv = bf2f(H[rr + C_GK]);
            *(LAS bf16*)(lds + G3_R0 + (64 * qt + i) * G3_P + ch * 2) = f2bf(qv * __expf(bb));
            *(LAS bf16*)(lds + G3_R1 + (64 * qt + i) * G3_P + ch * 2) = f2bf(kv * __expf(-bb));
        }
    }
    __syncthreads();
    const int fr = lane & 15, g4 = lane >> 4;
    const int tb0 = wid, tb1 = 15 - wid;
    bf16x8 qf[2][4];
#pragma unroll
    for (int ks = 0; ks < 4; ++ks) {
        qf[0][ks] = *(const LAS bf16x8*)(lds + G3_R0 + (16 * tb0 + fr) * G3_P + (32 * ks + 8 * g4) * 2);
        qf[1][ks] = *(const LAS bf16x8*)(lds + G3_R0 + (16 * tb1 + fr) * G3_P + (32 * ks + 8 * g4) * 2);
    }
    __syncthreads();
#pragma unroll 1
    for (int x = 0; x < 2; ++x) {
        const int tb = x ? tb1 : tb0;
#pragma unroll
        for (int i = 0; i < 8; ++i) { const int p = tid + 512 * i, rr = p >> 4, pc = p & 15;
            *(LAS u32x4*)(lds + G3_R0 + rr * G3_P + pc * 16) = *(const u32x4*)(SBUF + ((size_t)unit * 256 + rr) * 128 + pc * 8); }
        __syncthreads();
        bf16x8 qx[4];
#pragma unroll
        for (int ks = 0; ks < 4; ++ks) qx[ks] = x ? qf[1][ks] : qf[0][ks];
        f32x4 oT[16];
#pragma unroll
        for (int vb = 0; vb < 16; ++vb) oT[vb] = (f32x4){0.f, 0.f, 0.f, 0.f};
#pragma unroll
        for (int vb = 0; vb < 16; ++vb)
#pragma unroll
            for (int ks = 0; ks < 4; ++ks) { const bf16x8 sf = *(const LAS bf16x8*)(lds + G3_R0 + (16 * vb + fr) * G3_P + (32 * ks + 8 * g4) * 2);
                oT[vb] = MFMA16(sf, qx[ks], oT[vb]); }
        __syncthreads();
        const int jmax = x ? 3 : 1;
#pragma unroll 1
        for (int j = 0; j <= jmax; ++j) {
#pragma unroll
            for (int i = 0; i < 4; ++i) { const int p = tid + 512 * i, rr = p >> 5, pc = p & 31;
                *(LAS u32x4*)(lds + G3_R0 + rr * G3_VP + pc * 16) = *(const u32x4*)(H + (size_t)(row0 + 64 * j + rr) * HLD + C_GV + h * 256 + pc * 8); }
            __syncthreads();
            if ((tb >> 2) >= j) {
#pragma unroll
                for (int ks2 = 0; ks2 < 2; ++ks2) {
                    f32x4 aT[2];
#pragma unroll
                    for (int be = 0; be < 2; ++be) {
                        aT[be] = (f32x4){0.f, 0.f, 0.f, 0.f};
                        const int srow = 64 * j + 32 * ks2 + 8 * (fr >> 2) + 4 * be + (fr & 3);
#pragma unroll
                        for (int ks = 0; ks < 4; ++ks) { const bf16x8 kf = *(const LAS bf16x8*)(lds + G3_R1 + srow * G3_P + (32 * ks + 8 * g4) * 2); aT[be] = MFMA16(kf, qx[ks], aT[be]); }
                    }
                    if ((tb >> 2) == j) {
#pragma unroll
                        for (int be = 0; be < 2; ++be)
#pragma unroll
                            for (int i = 0; i < 4; ++i) if (32 * ks2 + 8 * g4 + 4 * be + i > 16 * (tb & 3) + fr) aT[be][i] = 0.f;
                    }
                    const bf16x8 pfx = pack8(aT[0], aT[1]);
#pragma unroll
                    for (int vb = 0; vb < 16; ++vb) { const bf16x8 vf = ld_tr(lds + G3_R0, G3_VP, 32 * ks2, 32 * vb, lane); oT[vb] = MFMA16(vf, pfx, oT[vb]); }
                }
            }
            __syncthreads();
        }
        {
            const int t = 16 * tb + fr; const size_t row = (size_t)row0 + t;
            float ss = 0.f;
#pragma unroll
            for (int vb = 0; vb < 16; ++vb)
#pragma unroll
                for (int i = 0; i < 4; ++i) ss += oT[vb][i] * oT[vb][i];
            ss += __shfl_xor(ss, 16); ss += __shfl_xor(ss, 32);
            const float rs = 1.0f / sqrtf(ss * (1.f / 256.f) + LN_EPS);
#pragma unroll
            for (int vb = 0; vb < 16; ++vb) { const int v = 16 * vb + 4 * g4; const f32x4 gn = *(const f32x4*)(gnorm + v);
                const u32x2 gw = *(const u32x2*)(H + row * HLD + C_GG + h * 256 + v);
                const f32x4 o = oT[vb] * rs * gn * (f32x4){bflo(gw.x), bfhi(gw.x), bflo(gw.y), bfhi(gw.y)};
                u32x2 wv; wv.x = pkbf(o[0], o[1]); wv.y = pkbf(o[2], o[3]); *(u32x2*)(OG + row * DM + h * 256 + v) = wv; }
        }
    }
}

constexpr int LDS_TAB = LDS_MISC + 16;
template <class T> __device__ __forceinline__ T* ldp(const LAS unsigned char* lds, int i) {
    const LAS unsigned* t = (const LAS unsigned*)(lds + LDS_TAB) + 2 * i;
    const unsigned lo = __builtin_amdgcn_readfirstlane(t[0]), hi = __builtin_amdgcn_readfirstlane(t[1]);
    return (T*)(GAS T*)(((unsigned long long)hi << 32) | lo);
}
__device__ __forceinline__ int lane_id_fresh() { int l; asm volatile("v_mbcnt_lo_u32_b32 %0, -1, 0\n\tv_mbcnt_hi_u32_b32 %0, -1, %0" : "=v"(l)); return l; }
#define PHASE_IDS() const int lane = lane_id_fresh(); const int tid = wid * 64 + lane; const int gt = bx * NTHREADS + tid; (void)gt
struct Args { const float* in[28]; float* outp; unsigned char* wsp; int ph_lo, ph_hi; };
constexpr int N_PHASES = 14;
#define x_prompt (ldp<const float>(lds, 0))
#define x_sample (ldp<const float>(lds, 1))
#define p_prompt (ldp<const float>(lds, 2))
#define p_sample (ldp<const float>(lds, 3))
#define state_gla (ldp<const float>(lds, 4))
#define cache_conv (ldp<const float>(lds, 5))
#define ck0 (ldp<const float>(lds, 6))
#define ck1 (ldp<const float>(lds, 7))
#define ck2 (ldp<const float>(lds, 8))
#define w_in (ldp<const float>(lds, 9))
#define w_gk_b (ldp<const float>(lds, 10))
#define b_gk (ldp<const float>(lds, 11))
#define gla_norm (ldp<const float>(lds, 12))
#define w_br_gla (ldp<const float>(lds, 13))
#define w_br_dil (ldp<const float>(lds, 14))
#define w_out (ldp<const float>(lds, 15))
#define ln1_g (ldp<const float>(lds, 16))
#define ln1_b (ldp<const float>(lds, 17))
#define w_up (ldp<const float>(lds, 18))
#define conv_w (ldp<const float>(lds, 19))
#define conv_b (ldp<const float>(lds, 20))
#define w_down (ldp<const float>(lds, 21))
#define ln2_g (ldp<const float>(lds, 22))
#define ln2_b (ldp<const float>(lds, 23))
#define w_ple_gate (ldp<const float>(lds, 24))
#define w_ple_proj (ldp<const float>(lds, 25))
#define ln3_g (ldp<const float>(lds, 26))
#define ln3_b (ldp<const float>(lds, 27))
#define RCOS ((float*)(ldp<unsigned char>(lds, 29) + WS_RCOS))
#define RSIN ((float*)(ldp<unsigned char>(lds, 29) + WS_RSIN))
#define BIN ((bf16*)(ldp<unsigned char>(lds, 29) + WS_BIN))
#define BBG ((bf16*)(ldp<unsigned char>(lds, 29) + WS_BBG))
#define BBD ((bf16*)(ldp<unsigned char>(lds, 29) + WS_BBD))
#define BOUT ((bf16*)(ldp<unsigned char>(lds, 29) + WS_BOUT))
#define BUP ((bf16*)(ldp<unsigned char>(lds, 29) + WS_BUP))
#define BDN ((bf16*)(ldp<unsigned char>(lds, 29) + WS_BDN))
#define BPG ((bf16*)(ldp<unsigned char>(lds, 29) + WS_BPG))
#define BPP ((bf16*)(ldp<unsigned char>(lds, 29) + WS_BPP))
#define XB ((bf16*)(ldp<unsigned char>(lds, 29) + WS_XB))
#define PEB ((bf16*)(ldp<unsigned char>(lds, 29) + WS_PEB))
#define GLR ((float*)(ldp<unsigned char>(lds, 29) + WS_GLR))
#define DC ((float*)(ldp<unsigned char>(lds, 29) + WS_DC))
#define LSE ((float*)(ldp<unsigned char>(lds, 29) + WS_LSE))
#define H ((bf16*)(ldp<unsigned char>(lds, 29) + WS_H))
#define LBUF ((float*)(ldp<unsigned char>(lds, 29) + WS_LBUF))
#define SBUF ((bf16*)(ldp<unsigned char>(lds, 29) + WS_SBUF))
#define OAT ((bf16*)(ldp<unsigned char>(lds, 29) + WS_OAT))
#define OD ((bf16*)(ldp<unsigned char>(lds, 29) + WS_OD))
#define OG ((bf16*)(ldp<unsigned char>(lds, 29) + WS_OG))
#define T ((float*)(ldp<unsigned char>(lds, 29) + WS_T))
#define MB ((bf16*)(ldp<unsigned char>(lds, 29) + WS_MB))
#define R ((float*)(ldp<unsigned char>(lds, 29) + WS_R))
#define X1 ((float*)(ldp<unsigned char>(lds, 29) + WS_X1))
#define X1B ((bf16*)(ldp<unsigned char>(lds, 29) + WS_X1B))
#define AB ((bf16*)(ldp<unsigned char>(lds, 29) + WS_AB))
#define HM ((bf16*)(ldp<unsigned char>(lds, 29) + WS_HM))
#define X2 ((float*)(ldp<unsigned char>(lds, 29) + WS_X2))
#define X2B ((bf16*)(ldp<unsigned char>(lds, 29) + WS_X2B))
#define PP ((float*)(ldp<unsigned char>(lds, 29) + WS_PP))
#define out (ldp<float>(lds, 28))

__global__ void __launch_bounds__(NTHREADS, 2) mk_fwd(Args args) {
    extern __shared__ __attribute__((aligned(16))) unsigned char lds_raw[];
    LAS unsigned char* lds = (LAS unsigned char*)lds_raw;
    const int wid = __builtin_amdgcn_readfirstlane((int)threadIdx.x >> 6);
    const int G = gridDim.x, bx = blockIdx.x;
    const int gw = bx * NWAVES + wid, NGW = G * NWAVES;
    const int NGT = G * NTHREADS;
    if (threadIdx.x < 4) ((LAS unsigned*)(lds + LDS_MISC))[threadIdx.x] = 0u;
    if (threadIdx.x == 0) {
        LAS unsigned long long* tab = (LAS unsigned long long*)(lds + LDS_TAB);
#pragma unroll
        for (int i = 0; i < 28; ++i) tab[i] = (unsigned long long)args.in[i];
        tab[28] = (unsigned long long)args.outp; tab[29] = (unsigned long long)args.wsp;
    }
    __syncthreads();
    unsigned* ctl = (unsigned*)(ldp<unsigned char>(lds, 29) + WS_CTL);
    const int lo = args.ph_lo, hi = args.ph_hi;
    const bool multi = (hi - lo) > 1;
    XcdBarrier bar; bar.bar = ctl + CW_BAR; bar.x = 0; bar.st = nullptr;
    if (multi) bar = xcd_barrier_post(ctl + CW_BAR, (volatile LAS unsigned*)(lds + LDS_MISC));
#ifndef PHMASK
#define PHMASK 0xffffffffu
#endif
#define IN(k) (((PHMASK >> (k)) & 1u) && lo <= (k) && (k) < hi)
#define SEAM(k) do { if (IN(k) && IN((k) + 1)) xcd_barrier(bar); } while (0)

    if (IN(0)) {
        PHASE_IDS();
        LAS float* scr = (LAS float*)(lds + wid * 16384);
        constexpr int I_IN = 16 * 305, I_BG = 16 * 32, I_BD = 8 * 32, I_OUT = 16 * 32, I_UP = 16 * 176, I_DN = 44 * 32, I_PG = 16 * 32, I_PP = 4 * 32;
        constexpr int NITEMS = I_IN + I_BG + I_BD + I_OUT + I_UP + I_DN + I_PG + I_PP;
        for (int it = gw; it < NITEMS; it += NGW) {
            int r = it;
            if (r < I_IN) { transpose_item<true>(w_in, 1024, 9744, BIN, scr, r, lane); continue; } r -= I_IN;
            if (r < I_BG) { transpose_item<false>(w_br_gla, 1024, 1024, BBG, scr, r, lane); continue; } r -= I_BG;
            if (r < I_BD) { transpose_item<false>(w_br_dil, 512, 1024, BBD, scr, r, lane); continue; } r -= I_BD;
            if (r < I_OUT) { transpose_item<false>(w_out, 1024, 1024, BOUT, scr, r, lane); continue; } r -= I_OUT;
            if (r < I_UP) { transpose_item<false>(w_up, 1024, 5632, BUP, scr, r, lane); continue; } r -= I_UP;
            if (r < I_DN) { transpose_item<false>(w_down, 2816, 1024, BDN, scr, r, lane); continue; } r -= I_DN;
            if (r < I_PG) { transpose_item<false>(w_ple_gate, 1024, 1024, BPG, scr, r, lane); continue; } r -= I_PG;
            transpose_item<false>(w_ple_proj, 256, 1024, BPP, scr, r, lane);
        }
        for (int i = gt; i < 240 * 128; i += NGT) *(u32x4*)(BIN + (size_t)9744 * 1024 + (size_t)i * 8) = (u32x4){0u, 0u, 0u, 0u};
        for (int m = gw; m < MROWS; m += NGW) {
            const float* xs = (m < MP) ? x_prompt + (size_t)m * DM : x_sample + (size_t)(m - MP) * DM;
            row_to_bf16(xs, XB + (size_t)m * DM, DM, lane);
            const float* ps = (m < MP) ? p_prompt + (size_t)m * 256 : p_sample + (size_t)(m - MP) * 256;
            row_to_bf16(ps, PEB + (size_t)m * 256, 256, lane);
        }
        for (int idx = gt; idx < 8200 * 32; idx += NGT) {
            const int pos = idx >> 5, i = idx & 31;
            const float a32 = (float)pos * kRopeInv[i];
            const double a = (double)a32;
            const double n = rint(a * 0.15915494309189535);
            double rr = fma(-n, 6.283185307179586, a); rr = fma(-n, 2.4492935982947064e-16, rr);
            const double r2 = rr * rr;
            double sp = -1.0 / 25852016738884976640000.0;
            sp = sp * r2 + 1.0 / 51090942171709440000.0;
            sp = sp * r2 - 1.0 / 121645100408832000.0;
            sp = sp * r2 + 1.0 / 355687428096000.0;
            sp = sp * r2 - 1.0 / 1307674368000.0;
            sp = sp * r2 + 1.0 / 6227020800.0;
            sp = sp * r2 - 1.0 / 39916800.0;
            sp = sp * r2 + 1.0 / 362880.0;
            sp = sp * r2 - 1.0 / 5040.0;
            sp = sp * r2 + 1.0 / 120.0;
            sp = sp * r2 - 1.0 / 6.0;
            sp = sp * r2 + 1.0;
            double cp = 1.0 / 620448401733239439360000.0;
            cp = cp * r2 - 1.0 / 1124000727777607680000.0;
            cp = cp * r2 + 1.0 / 2432902008176640000.0;
            cp = cp * r2 - 1.0 / 6402373705728000.0;
            cp = cp * r2 + 1.0 / 20922789888000.0;
            cp = cp * r2 - 1.0 / 87178291200.0;
            cp = cp * r2 + 1.0 / 479001600.0;
            cp = cp * r2 - 1.0 / 3628800.0;
            cp = cp * r2 + 1.0 / 40320.0;
            cp = cp * r2 - 1.0 / 720.0;
            cp = cp * r2 + 1.0 / 24.0;
            cp = cp * r2 - 0.5;
            cp = cp * r2 + 1.0;
            RCOS[idx] = (float)cp; RSIN[idx] = (float)(sp * rr);
        }
    }
    SEAM(0);

    if (IN(1)) {
        pg8::GemmX g{XB, XB + (size_t)MP * DM, BIN, NIN, DM}; pg8::OrderX S; S.init(NIN, G, bx);
        pg8::EpiIn E{H, GLR, RCOS, RSIN, out};
        pg8::gemm_phase_x<pg8::EpiIn>(lds, g, S, E);
    }
    SEAM(1);

    if (IN(2)) {
        PHASE_IDS();
        const bool dec_first = (bx & 1) != 0;
#ifndef P2R_DEC
#define P2R_DEC 1
#define P2R_G1 1
#define P2R_GS 1
#define P2R_ATT 1
#endif
        if (dec_first) { for (int rep = 0; rep < P2R_DEC; ++rep) for (int u = bx; u < 1664; u += G) attn_dec_unit(lds, u, ck0, ck1, ck2, H, OAT, LSE, lane, wid); __syncthreads(); }
        for (int rep = 0; rep < P2R_G1; ++rep) for (int u = bx; u < 256; u += G) g1_unit(lds, u, H, GLR, w_gk_b, b_gk, LBUF, DC, tid, lane, wid);
        __syncthreads();
        for (int rep = 0; rep < P2R_GS; ++rep) for (int u = bx; u < 512; u += G) gla_sample_unit(lds, u, H, GLR, w_gk_b, b_gk, state_gla, gla_norm, out, OG, tid, lane, wid);
        __syncthreads();
        for (int rep = 0; rep < P2R_ATT; ++rep) attn_prompt_phase(lds, bx, G, 3072, H, OAT, LSE, tid, lane, wid);
        __syncthreads();
        if (!dec_first) { for (int rep = 0; rep < P2R_DEC; ++rep) for (int u = bx; u < 1664; u += G) attn_dec_unit(lds, u, ck0, ck1, ck2, H, OAT, LSE, lane, wid); }
    }
    SEAM(2);

    if (IN(3)) {
        PHASE_IDS();
        for (int e = gt; e < 8 * 32768; e += NGT) {
            const int bh = e >> 15, idx = e & 32767, v = idx >> 7, k = idx & 127;
            float s = 0.f;
#pragma unroll 1
            for (int c0 = 0; c0 < 32; c0 += 8) {
                float lv[8], dv[8];
#pragma unroll
                for (int c = 0; c < 8; ++c) { const int unit = bh * 32 + c0 + c; lv[c] = LBUF[(size_t)unit * 32768 + idx]; dv[c] = DC[unit * 128 + k]; }
#pragma unroll
                for (int c = 0; c < 8; ++c) { const int unit = bh * 32 + c0 + c; SBUF[(size_t)unit * 32768 + idx] = f2bf(s); s = dv[c] * s + lv[c]; }
            }
            out[OFF_GSP + ((size_t)bh * 128 + k) * 256 + v] = s;
        }
        for (int e = gt; e < MROWS * 64; e += NGT) {
            const int row = e >> 6, pc = e & 63, hh = pc >> 3;
            const float l0 = LSE[((size_t)0 * MROWS + row) * 8 + hh], l1 = LSE[((size_t)1 * MROWS + row) * 8 + hh], l2 = LSE[((size_t)2 * MROWS + row) * 8 + hh];
            const float mx = fmaxf(l0, fmaxf(l1, l2));
            float w0 = __builtin_amdgcn_exp2f(l0 - mx), w1 = __builtin_amdgcn_exp2f(l1 - mx), w2 = __builtin_amdgcn_exp2f(l2 - mx);
            const float inv = 1.0f / (w0 + w1 + w2); w0 *= inv; w1 *= inv; w2 *= inv;
            const u32x4 a = *(const u32x4*)(OAT + ((size_t)0 * MROWS + row) * 512 + pc * 8), bq = *(const u32x4*)(OAT + ((size_t)1 * MROWS + row) * 512 + pc * 8), cq = *(const u32x4*)(OAT + ((size_t)2 * MROWS + row) * 512 + pc * 8);
            u32x4 o;
            o.x = pkbf(w0 * bflo(a.x) + w1 * bflo(bq.x) + w2 * bflo(cq.x), w0 * bfhi(a.x) + w1 * bfhi(bq.x) + w2 * bfhi(cq.x));
            o.y = pkbf(w0 * bflo(a.y) + w1 * bflo(bq.y) + w2 * bflo(cq.y), w0 * bfhi(a.y) + w1 * bfhi(bq.y) + w2 * bfhi(cq.y));
            o.z = pkbf(w0 * bflo(a.z) + w1 * bflo(bq.z) + w2 * bflo(cq.z), w0 * bfhi(a.z) + w1 * bfhi(bq.z) + w2 * bfhi(cq.z));
            o.w = pkbf(w0 * bflo(a.w) + w1 * bflo(bq.w) + w2 * bflo(cq.w), w0 * bfhi(a.w) + w1 * bfhi(bq.w) + w2 * bfhi(cq.w));
            *(u32x4*)(OD + (size_t)row * 512 + pc * 8) = o;
        }
    }
    SEAM(3);

    if (IN(4)) {
        PHASE_IDS();
        for (int u = bx; u < 256; u += G) { g3_unit(lds, u, H, GLR, w_gk_b, b_gk, SBUF, gla_norm, OG, tid, lane, wid); __syncthreads(); }
    }
    SEAM(4);

    if (IN(5)) {
        { pg8::GemmX g{OG, OG + (size_t)MP * DM, BBG, DM, DM}; pg8::OrderX S; S.init(DM, G, bx); pg8::EpiGateT E{H + C_GA, HLD, T};
          pg8::gemm_phase_x<pg8::EpiGateT>(lds, g, S, E); }
        __syncthreads();
        { pg8::GemmX g{OD, OD + (size_t)MP * 512, BBD, DM, 512}; pg8::OrderX S; S.init(DM, G, bx); pg8::EpiGateM E{H + C_GB, HLD, T, MB};
          pg8::gemm_phase_x<pg8::EpiGateM>(lds, g, S, E); }
    }
    SEAM(5);

    if (IN(6)) {
        { pg8::GemmX g{MB, MB + (size_t)MP * DM, BOUT, DM, DM}; pg8::OrderX S; S.init(DM, G, bx); pg8::EpiRes E{x_prompt, x_sample, R};
          pg8::gemm_phase_x<pg8::EpiRes>(lds, g, S, E); }
        __syncthreads();
        { pg8::GemmX g{PEB, PEB + (size_t)MP * 256, BPP, DM, 256}; pg8::OrderX S; S.init(DM, G, bx); pg8::EpiF32 E{PP};
          pg8::gemm_phase_x<pg8::EpiF32>(lds, g, S, E); }
    }
    SEAM(6);
    if (IN(7)) { PHASE_IDS(); ln_pass(R, ln1_g, ln1_b, X1, X1B, gw, NGW, lane); }
    SEAM(7);
    if (IN(8)) {
        pg8::GemmX g{X1B, X1B + (size_t)MP * DM, BUP, FF, DM}; pg8::OrderX S; S.init(FF, G, bx); pg8::EpiA E{AB, out};
        pg8::gemm_phase_x<pg8::EpiA>(lds, g, S, E);
    }
    SEAM(8);
    if (IN(9)) {
        pg8::GemmX g{X1B, X1B + (size_t)MP * DM, BUP + (size_t)FF * DM, FF, DM}; pg8::OrderX S; S.init(FF, G, bx); pg8::EpiU E{AB, cache_conv, conv_w, conv_b, HM};
        pg8::gemm_phase_x<pg8::EpiU>(lds, g, S, E);
    }
    SEAM(9);
    if (IN(10)) {
        pg8::GemmX g{HM, HM + (size_t)MP * FF, BDN, DM, FF}; pg8::OrderX S; S.init(DM, G, bx); pg8::EpiRes E{X1, X1 + (size_t)MP * DM, R};
        pg8::gemm_phase_x<pg8::EpiRes>(lds, g, S, E);
    }
    SEAM(10);
    if (IN(11)) { PHASE_IDS(); ln_pass(R, ln2_g, ln2_b, X2, X2B, gw, NGW, lane); }
    SEAM(11);
    if (IN(12)) {
        pg8::GemmX g{X2B, X2B + (size_t)MP * DM, BPG, DM, DM}; pg8::OrderX S; S.init(DM, G, bx); pg8::EpiPle E{X2, PP, R};
        pg8::gemm_phase_x<pg8::EpiPle>(lds, g, S, E);
    }
    SEAM(12);
    if (IN(13)) { PHASE_IDS(); ln_pass(R, ln3_g, ln3_b, out + OFF_Y, nullptr, gw, NGW, lane); }
#undef IN
#undef SEAM
}

#undef x_prompt
#undef x_sample
#undef p_prompt
#undef p_sample
#undef state_gla
#undef cache_conv
#undef ck0
#undef ck1
#undef ck2
#undef w_in
#undef w_gk_b
#undef b_gk
#undef gla_norm
#undef w_br_gla
#undef w_br_dil
#undef w_out
#undef ln1_g
#undef ln1_b
#undef w_up
#undef conv_w
#undef conv_b
#undef w_down
#undef ln2_g
#undef ln2_b
#undef w_ple_gate
#undef w_ple_proj
#undef ln3_g
#undef ln3_b
#undef RCOS
#undef RSIN
#undef BIN
#undef BBG
#undef BBD
#undef BOUT
#undef BUP
#undef BDN
#undef BPG
#undef BPP
#undef XB
#undef PEB
#undef GLR
#undef DC
#undef LSE
#undef H
#undef LBUF
#undef SBUF
#undef OAT
#undef OD
#undef OG
#undef T
#undef MB
#undef R
#undef X1
#undef X1B
#undef AB
#undef HM
#undef X2
#undef X2B
#undef PP
#undef out
#ifndef MK_N_LAUNCHES
#define MK_N_LAUNCHES 1
#endif
extern "C" void kernel_launch(void* const* d_in, const int* in_sizes, int n_in, void* d_out, int out_size, void* d_ws, size_t ws_size, hipStream_t stream) {
    static int grid = 0;
    if (grid == 0) {
        if (n_in != 28 || out_size != (int)OUT_TOTAL || ws_size < WS_END) { fprintf(stderr, "kernel_launch: unexpected sizes (n_in %d, out %d, ws %zu)\n", n_in, out_size, ws_size); grid = -1; return; }
        int dev = 0, cus = 0, per_cu = 0;
        if (hipGetDevice(&dev) != hipSuccess || hipDeviceGetAttribute(&cus, hipDeviceAttributeMultiprocessorCount, dev) != hipSuccess) { grid = -1; return; }
        if (hipFuncSetAttribute((const void*)mk_fwd, hipFuncAttributeMaxDynamicSharedMemorySize, LDS_BYTES) != hipSuccess) { fprintf(stderr, "kernel_launch: hipFuncSetAttribute failed\n"); grid = -1; return; }
        if (hipOccupancyMaxActiveBlocksPerMultiprocessor(&per_cu, (const void*)mk_fwd, NTHREADS, LDS_BYTES) != hipSuccess || per_cu < 1) { fprintf(stderr, "kernel_launch: occupancy query says %d\n", per_cu); }
        (void)hipGetLastError();
        grid = cus;
    }
    if (grid < 0) return;
    (void)hipMemsetAsync((char*)d_ws + WS_CTL, 0, CTL_ZERO_BYTES, stream);
    Args a{};
    for (int i = 0; i < 28; ++i) a.in[i] = (const float*)d_in[i];
    a.outp = (float*)d_out; a.wsp = (unsigned char*)d_ws;
    if (MK_N_LAUNCHES == 1) { a.ph_lo = 0; a.ph_hi = N_PHASES; hipLaunchKernelGGL(mk_fwd, dim3(grid), dim3(NTHREADS), LDS_BYTES, stream, a); }
    else { for (int p = 0; p < N_PHASES; ++p) { a.ph_lo = p; a.ph_hi = p + 1; hipLaunchKernelGGL(mk_fwd, dim3(grid), dim3(NTHREADS), LDS_BYTES, stream, a);
#ifdef MK_DUPMASK
            if ((MK_DUPMASK >> p) & 1) hipLaunchKernelGGL(mk_fwd, dim3(grid), dim3(NTHREADS), LDS_BYTES, stream, a);
#endif
        } }
}
```
